# Optimizing an MI355X kernel written in HIP

```python
import jax, jax.numpy as jnp
from jax import lax
import numpy as np

D_MODEL = 1024
BATCH = 8
SEQ = 2048
DEPTH = 1

CHUNK = 128
N_SGU_GROUPS = 8
SGU_WIDTH = D_MODEL
SGU_GROUP = SGU_WIDTH // N_SGU_GROUPS
CONV_WIDTH = D_MODEL
CONV_K = 3
PROJ_WIDTHS = (SGU_WIDTH, SGU_WIDTH, CONV_WIDTH, CONV_WIDTH, CONV_WIDTH, D_MODEL, D_MODEL)
PROJ_TOTAL = sum(PROJ_WIDTHS)
PROJ_SPLITS = tuple(int(i) for i in np.cumsum(PROJ_WIDTHS)[:-1])
N_EXPERT_GROUPS = 8
EXPERTS_PER_GROUP = 8
N_EXPERTS = N_EXPERT_GROUPS * EXPERTS_PER_GROUP
TOP_K = 2
D_EXPERT = D_MODEL // 2
MOE_BLOCK = 128
EPS = 1e-6

kernel_name = "hybrid_sgu_shortconv_hiermoe_encoder"


def _rmsnorm(x, g):
    x32 = x.astype(jnp.float32)
    y = x32 * lax.rsqrt(jnp.mean(x32 * x32, axis=-1, keepdims=True) + EPS)
    return (y * g.astype(jnp.float32)).astype(x.dtype)


def _group_layernorm(v, g):
    v32 = v.astype(jnp.float32)
    mu = jnp.mean(v32, axis=-1, keepdims=True)
    d = v32 - mu
    var = jnp.mean(d * d, axis=-1, keepdims=True)
    return (d * lax.rsqrt(var + EPS) * g.astype(jnp.float32)).astype(v.dtype)


def _spatial_gate(u, v, w_s, b_s, g_ln):
    b, s, _ = v.shape
    nc = s // CHUNK
    vg = v.reshape(b, nc, CHUNK, N_SGU_GROUPS, SGU_GROUP)
    vg = _group_layernorm(vg, g_ln.reshape(N_SGU_GROUPS, SGU_GROUP))
    z = jnp.einsum('gqp,bnpgc->bnqgc', w_s, vg) + b_s.T[None, None, :, :, None]
    return u * z.reshape(b, s, SGU_WIDTH)


def _short_conv(z, w):
    s = z.shape[1]
    half = CONV_K // 2
    zp = jnp.pad(z, ((0, 0), (half, half), (0, 0)))
    out = w[0] * zp[:, 0:s]
    for k in range(1, CONV_K):
        out = out + w[k] * zp[:, k:k + s]
    return out


def _hier_moe(h, w_rg, w_re, w_gate, w_up, w_down):
    t = h.shape[0]
    g_logits = (h @ w_rg).astype(jnp.float32)
    g_prob = jax.nn.softmax(g_logits, axis=-1)
    g_idx = jnp.argmax(g_logits, axis=-1).astype(jnp.int32)
    p_g = jnp.take_along_axis(g_prob, g_idx[:, None], axis=1)
    e_logits = (h @ w_re).astype(jnp.float32).reshape(t, N_EXPERT_GROUPS, EXPERTS_PER_GROUP)
    e_logits = jnp.take_along_axis(e_logits, g_idx[:, None, None], axis=1)[:, 0]
    top_l, top_i = lax.top_k(e_logits, TOP_K)
    gate = p_g * jax.nn.softmax(top_l, axis=-1)

    eid = (g_idx[:, None] * EXPERTS_PER_GROUP + top_i).reshape(-1).astype(jnp.int32)
    tok = jnp.repeat(jnp.arange(t, dtype=jnp.int32), TOP_K)
    wt = gate.reshape(-1)
    order = jnp.argsort(eid)
    eid_s, tok_s, wt_s = eid[order], tok[order], wt[order]

    counts = jnp.bincount(eid, length=N_EXPERTS).astype(jnp.int32)
    padded = ((counts + MOE_BLOCK - 1) // MOE_BLOCK) * MOE_BLOCK
    start = jnp.cumsum(counts) - counts
    pend = jnp.cumsum(padded)
    pstart = pend - padded
    n_assign = t * TOP_K
    n_rows = -(-(n_assign + N_EXPERTS * (MOE_BLOCK - 1)) // MOE_BLOCK) * MOE_BLOCK
    n_blocks = n_rows // MOE_BLOCK

    dest = pstart[eid_s] + jnp.arange(n_assign, dtype=jnp.int32) - start[eid_s]
    row_tok = jnp.zeros((n_rows,), jnp.int32).at[dest].set(tok_s)
    row_w = jnp.zeros((n_rows,), h.dtype).at[dest].set(wt_s.astype(h.dtype))
    blk_start = jnp.arange(n_blocks, dtype=jnp.int32) * MOE_BLOCK
    blk_e = jnp.minimum(jnp.searchsorted(pend, blk_start, side='right'), N_EXPERTS - 1).astype(jnp.int32)

    xb = h[row_tok].reshape(n_blocks, MOE_BLOCK, h.shape[-1])

    def expert_block(args):
        xe, e = args
        hid = jax.nn.silu(xe @ w_gate[e]) * (xe @ w_up[e])
        return hid @ w_down[e]

    yb = lax.map(expert_block, (xb, blk_e))
    y_rows = yb.reshape(n_rows, -1) * row_w[:, None]
    return jnp.zeros_like(h).at[row_tok].add(y_rows)


def setup_inputs(seed: int = 0) -> dict:
    key = jax.random.key(seed)
    ks = jax.random.split(key, 16)
    f32 = jnp.float32
    nrm = lambda k, shape, scale: (jax.random.normal(k, shape, f32) * scale).astype(f32)
    x = jax.random.normal(ks[0], (BATCH, SEQ, D_MODEL), f32)
    g_mix = 1.0 + nrm(ks[1], (DEPTH, D_MODEL), 0.02)
    w_in = nrm(ks[2], (DEPTH, D_MODEL, PROJ_TOTAL), D_MODEL ** -0.5)
    w_s = nrm(ks[3], (DEPTH, N_SGU_GROUPS, CHUNK, CHUNK), CHUNK ** -0.5)
    b_s = 1.0 + nrm(ks[4], (DEPTH, N_SGU_GROUPS, CHUNK), 0.02)
    g_sgu = 1.0 + nrm(ks[5], (DEPTH, SGU_WIDTH), 0.02)
    w_conv = nrm(ks[6], (DEPTH, CONV_K, CONV_WIDTH), CONV_K ** -0.5)
    w_out = nrm(ks[7], (DEPTH, D_MODEL, D_MODEL), D_MODEL ** -0.5)
    g_ffn = 1.0 + nrm(ks[8], (DEPTH, D_MODEL), 0.02)
    w_router_group = nrm(ks[9], (DEPTH, D_MODEL, N_EXPERT_GROUPS), D_MODEL ** -0.5)
    w_router_expert = nrm(ks[10], (DEPTH, D_MODEL, N_EXPERTS), D_MODEL ** -0.5)
    w_gate = nrm(ks[11], (DEPTH, N_EXPERTS, D_MODEL, D_EXPERT), D_MODEL ** -0.5)
    w_up = nrm(ks[12], (DEPTH, N_EXPERTS, D_MODEL, D_EXPERT), D_MODEL ** -0.5)
    w_down = nrm(ks[13], (DEPTH, N_EXPERTS, D_EXPERT, D_MODEL), D_EXPERT ** -0.5)
    g_final = 1.0 + nrm(ks[14], (D_MODEL,), 0.02)
    return {"x": x, "g_mix": g_mix, "w_in": w_in, "w_s": w_s, "b_s": b_s,
            "g_sgu": g_sgu, "w_conv": w_conv, "w_out": w_out, "g_ffn": g_ffn,
            "w_router_group": w_router_group, "w_router_expert": w_router_expert,
            "w_gate": w_gate, "w_up": w_up, "w_down": w_down, "g_final": g_final}


def reference(x, g_mix, w_in, w_s, b_s, g_sgu, w_conv, w_out, g_ffn,
              w_router_group, w_router_expert, w_gate, w_up, w_down, g_final):
    for l in range(DEPTH):
        h = _rmsnorm(x, g_mix[l])
        proj = h @ w_in[l]
        u, v, cb, cc, xc, ga, gb = jnp.split(proj, PROJ_SPLITS, axis=-1)
        y_a = _spatial_gate(jax.nn.gelu(u), jax.nn.gelu(v), w_s[l], b_s[l], g_sgu[l])
        y_b = cb * _short_conv(cc * xc, w_conv[l])
        merged = jax.nn.sigmoid(ga) * y_a + jax.nn.sigmoid(gb) * y_b
        x = x + merged @ w_out[l]
        h2 = _rmsnorm(x, g_ffn[l]).reshape(-1, D_MODEL)
        y_moe = _hier_moe(h2, w_router_group[l], w_router_expert[l],
                          w_gate[l], w_up[l], w_down[l])
        x = x + y_moe.reshape(x.shape)
    return _rmsnorm(x, g_final)
```

```cpp
#include <hip/hip_runtime.h>
#include <cstdio>
#include <cstdint>
#define DEBUG_CHECK 0
#define N_LAUNCH_PER_PHASE 0
#define GAS __attribute__((address_space(1)))
#define LAS __attribute__((address_space(3)))
typedef unsigned short bf16_t;
typedef short bf16x8 __attribute__((ext_vector_type(8)));
typedef float f32x4 __attribute__((ext_vector_type(4)));
typedef float f32x2 __attribute__((ext_vector_type(2)));
typedef unsigned u32x4 __attribute__((ext_vector_type(4)));
typedef unsigned u32x2 __attribute__((ext_vector_type(2)));
typedef unsigned short u16x4 __attribute__((ext_vector_type(4)));

constexpr int T = 16384, D = 1024, NP = 7168, NE = 64, DE = 512, SEQ = 2048, LCAP = 16384;
constexpr float EPS = 1e-6f;
constexpr int NWAVES = 8, NTHR = 512;

#define RLX_AGENT __ATOMIC_RELAXED, __HIP_MEMORY_SCOPE_AGENT
#define LDS_WAIT() asm volatile("s_waitcnt lgkmcnt(0)" ::: "memory")
#define VM_WAIT() asm volatile("s_waitcnt vmcnt(0)" ::: "memory")

__device__ __forceinline__ unsigned cvt_pk_bf16(float lo, float hi) { unsigned r; asm volatile("v_cvt_pk_bf16_f32 %0, %1, %2" : "=v"(r) : "v"(lo), "v"(hi)); return r; }
__device__ __forceinline__ float bf_lo(unsigned w) { return __uint_as_float(w << 16); }
__device__ __forceinline__ float bf_hi(unsigned w) { return __uint_as_float(w & 0xffff0000u); }
__device__ __forceinline__ float wave_sum(float v) {
#pragma unroll
    for (int o = 1; o < 64; o <<= 1) v += __shfl_xor(v, o);
    return v;
}
__device__ __forceinline__ float fast_sigm(float y) { return __builtin_amdgcn_rcpf(1.0f + __builtin_amdgcn_exp2f(-1.4426950408889634f * y)); }
__device__ __forceinline__ float fast_gelu(float x) { return x * fast_sigm(1.5957691216057308f * (x + 0.044715f * x * x * x)); }

#define XB_TMO      128
#define XB_XCNT(j)  (256  + 64 * (j))
#define XB_XSUB(j)  (1280 + 64 * (j))
#define XB_XGEN(j)  (2304 + 64 * (j))
#define XB_TOP      3328
#define XB_TOPGEN   3392
#define XCD_BAR_WORDS 3456
#define XB_SPIN_CAP (1u << 18)
__device__ __forceinline__ unsigned xb_ld(unsigned* p)              { return __hip_atomic_load(p, __ATOMIC_RELAXED, __HIP_MEMORY_SCOPE_AGENT); }
__device__ __forceinline__ unsigned xb_add(unsigned* p, unsigned v) { return __hip_atomic_fetch_add(p, v, __ATOMIC_RELAXED, __HIP_MEMORY_SCOPE_AGENT); }
__device__ __forceinline__ unsigned xb_xcc_id() { return (unsigned)__builtin_amdgcn_s_getreg((3 << 11) | 20) & 0xFu; }
#define XB_SPIN(cond, bar) do { unsigned _sp = 0; while (cond) { __builtin_amdgcn_s_sleep(1); \
    if ((++_sp & 255u) == 0u) { if (xb_ld(&(bar)[XB_TMO])) break; if (_sp > XB_SPIN_CAP) { atomicAdd(&(bar)[XB_TMO], 1u); break; } } } } while (0)
struct XcdBarrier { unsigned* bar; unsigned x; volatile LAS unsigned* st; };
__device__ __forceinline__ XcdBarrier xcd_barrier_post(unsigned* bar, volatile LAS unsigned* st) {
    XcdBarrier b; b.bar = bar; b.x = xb_xcc_id(); b.st = st;
    if (threadIdx.x == 0) (void)xb_add(&bar[XB_XCNT(b.x)], 1u);
    return b;
}
__device__ __forceinline__ void xcd_barrier_complete(unsigned* bar, unsigned x, unsigned& nloc, unsigned& nx) {
    const unsigned G = gridDim.x * gridDim.y * gridDim.z;
    unsigned sum, cnt, mine, sp = 0u;
    for (;;) {
        sum = 0u; cnt = 0u; mine = 0u;
#pragma unroll
        for (unsigned j = 0; j < 16; ++j) { const unsigned c = xb_ld(&bar[XB_XCNT(j)]); sum += c; cnt += (c > 0u) ? 1u : 0u; mine = (j == x) ? c : mine; }
        if (sum == G) break;
        __builtin_amdgcn_s_sleep(1);
        if ((++sp & 255u) == 0u) { if (xb_ld(&bar[XB_TMO])) break; if (sp > XB_SPIN_CAP) { atomicAdd(&bar[XB_TMO], 1u); break; } }
    }
    nloc = mine > 0u ? mine : 1u; nx = cnt > 0u ? cnt : 1u;
}
__device__ __forceinline__ void xcd_barrier(const XcdBarrier& b) {
    asm volatile("s_waitcnt vmcnt(0)" ::: "memory");
    __syncthreads();
    if (threadIdx.x == 0) {
        unsigned* bar = b.bar;
        __builtin_amdgcn_s_waitcnt(0);
        unsigned nloc = b.st[0], nx = b.st[1];
        if (nloc == 0u) { xcd_barrier_complete(bar, b.x, nloc, nx); b.st[0] = nloc; b.st[1] = nx; }
        const unsigned old = xb_add(&bar[XB_XSUB(b.x)], 1u);
        const unsigned gen = old / nloc;
        if (old + 1u == (gen + 1u) * nloc) {
            __builtin_amdgcn_fence(__ATOMIC_RELEASE, "agent");
            asm volatile("s_waitcnt vmcnt(0)" ::: "memory");
            const unsigned og = xb_add(&bar[XB_TOP], 1u);
            const unsigned tg = og / nx;
            if (og + 1u == (tg + 1u) * nx) xb_add(&bar[XB_TOPGEN], 1u);
            else XB_SPIN(xb_ld(&bar[XB_TOPGEN]) == tg, bar);
            __builtin_amdgcn_fence(__ATOMIC_ACQUIRE, "agent");
            xb_add(&bar[XB_XGEN(b.x)], 1u);
            asm volatile("s_waitcnt vmcnt(0)" ::: "memory");
        } else {
            XB_SPIN(xb_ld(&bar[XB_XGEN(b.x)]) == gen, bar);
            __builtin_amdgcn_fence(__ATOMIC_ACQUIRE, "agent");
            asm volatile("s_waitcnt vmcnt(0)" ::: "memory");
        }
    }
    __syncthreads();
}

namespace pg8 {
constexpr int BM = 256, BK = 64, HALF = 128, HTB = HALF * BK * 2, STAGE_BYTES = 8 * HTB, NXCD = 8, WGM = 8;
__host__ __device__ __forceinline__ int lds_byte(int r, int c) { const int st = (r >> 4) * 2 + (c >> 5), rr = r & 15, cc = c & 31, ob = rr * 64 + cc * 2; return st * 1024 + (ob ^ (((ob >> 9) & 1) << 5)); }
__host__ __device__ __forceinline__ void stage_rc(int b, int& R, int& C) { const int st = b / 1024, sb = b % 1024, swz = sb ^ (((sb >> 9) & 1) << 5); R = (st >> 1) * 16 + swz / 64; C = (st & 1) * 32 + (swz % 64) / 2; }
__host__ __device__ __forceinline__ int perm32(int rho) { const int n = rho >> 4, i = rho & 15; return 8 * (i >> 2) + 4 * n + (i & 3); }
__host__ __device__ __forceinline__ int xcd_remap(int L, int nwg) { const int q = nwg / NXCD, r = nwg % NXCD, xcd = L % NXCD, off = L / NXCD; return (xcd < r ? xcd * (q + 1) : r * (q + 1) + (xcd - r) * q) + off; }

struct Unit { const char* a; const char* b; int m0, n0, e, cnt, lb; };

struct StaticOrder {
    int nM, nN, nwg, G, c;
    __host__ __device__ void init(int M, int N, int G_, int c_) { nM = M / BM; nN = N / BM; nwg = nM * nN; G = G_; c = c_; }
    __host__ __device__ bool next(int i, int& pm, int& pn) const {
        const long L = (long)i * G + c; if (L >= nwg) return false;
        const int wgid = xcd_remap((int)L, nwg);
        const int nig = WGM * nN, gid = wgid / nig, fm = gid * WGM, gsz = (nM - fm) < WGM ? (nM - fm) : WGM;
        pm = fm + ((wgid % nig) % gsz); pn = (wgid % nig) / gsz; return true;
    }
};

template <class P>
__device__ __forceinline__ void gemm_phase(LAS unsigned char* lds, const P& S) {
    constexpr int K = P::K, nt = K / BK;
    const int tid = threadIdx.x, wid = __builtin_amdgcn_readfirstlane(tid >> 6), lane = tid & 63, wr = wid >> 2, wc = wid & 3, fr = lane & 15, fq = lane >> 4;
    int Rs[2], Cs[2]; unsigned voffB[2];
#pragma unroll
    for (int i = 0; i < 2; ++i) { int R, C; stage_rc(tid * 16 + i * 8192, R, C); Rs[i] = R; Cs[i] = C; const int Rb = P::PERM ? ((R & ~31) + perm32(R & 31)) : R; voffB[i] = (unsigned)(Rb * K + C) * 2u; }
    constexpr size_t kstep = (size_t)(BK * 2);
    constexpr size_t hstep = (size_t)HALF * K * 2;
    const unsigned ldsw = (unsigned)wid * 1024u;
    const int aoff = lds_byte(wr * 64 + fr, fq * 8), boff = lds_byte(wc * 32 + fr, fq * 8);
#define PG8_SA(b, h) (((b) * 2 + (h)) * HTB)
#define PG8_SB(b, h) ((4 + (b) * 2 + (h)) * HTB)
#define PG8_STAGE_B(bufoff, gbase) do { _Pragma("unroll") for (int _i = 0; _i < 2; ++_i) \
        __builtin_amdgcn_global_load_lds((const unsigned*)((const char*)(gbase) + voffB[_i]), (LAS unsigned*)(lds + (bufoff) + ldsw + _i * 8192), 16, 0, 0); } while (0)
#define PG8_STAGE_A(bufoff, gbase, offs, h) do { _Pragma("unroll") for (int _i = 0; _i < 2; ++_i) \
        __builtin_amdgcn_global_load_lds((const unsigned*)((const char*)(gbase) + (offs)[h][_i]), (LAS unsigned*)(lds + (bufoff) + ldsw + _i * 8192), 16, 0, 0); } while (0)
#define PG8_LDA(dst, b, h) do { _Pragma("unroll") for (int m = 0; m < 4; ++m) _Pragma("unroll") for (int k = 0; k < 2; ++k) dst[m][k] = *(const LAS bf16x8*)(lds + PG8_SA(b, h) + aoff + m * 2048 + k * 1024); } while (0)
#define PG8_LDB(dst, b, h) do { _Pragma("unroll") for (int n = 0; n < 2; ++n) _Pragma("unroll") for (int k = 0; k < 2; ++k) dst[n][k] = *(const LAS bf16x8*)(lds + PG8_SB(b, h) + boff + n * 2048 + k * 1024); } while (0)
#define PG8_MMA(ai, bj, At, Bt) do { __builtin_amdgcn_s_setprio(1); _Pragma("unroll") for (int m = 0; m < 4; ++m) _Pragma("unroll") for (int n = 0; n < 2; ++n) _Pragma("unroll") for (int k = 0; k < 2; ++k) \
        acc[ai][bj][m][n] = __builtin_amdgcn_mfma_f32_16x16x32_bf16(Bt[n][k], At[m][k], acc[ai][bj][m][n], 0, 0, 0); __builtin_amdgcn_s_setprio(0); } while (0)
#define PG8_WAIT_V(n) asm volatile("s_waitcnt vmcnt(" #n ")" ::: "memory")
#define PG8_WAIT_L(n) asm volatile("s_waitcnt lgkmcnt(" #n ")" ::: "memory")
#define PG8_BAR __builtin_amdgcn_s_barrier()
#define PG8_SCHED __builtin_amdgcn_sched_barrier(0)
    Unit cur, nxt; int ui = 0;
    if (!S.next(0, cur)) return;
    f32x4 acc[2][2][4][2];
#pragma unroll
    for (int a = 0; a < 2; ++a)
#pragma unroll
        for (int b = 0; b < 2; ++b)
#pragma unroll
            for (int m = 0; m < 4; ++m)
#pragma unroll
                for (int n = 0; n < 2; ++n) acc[a][b][m][n] = (f32x4){0.f, 0.f, 0.f, 0.f};
    bf16x8 At[4][2], B0[2][2], B1[2][2];
    unsigned vAc[2][2], vAn[2][2];
#pragma unroll
    for (int h = 0; h < 2; ++h)
#pragma unroll
        for (int i = 0; i < 2; ++i) {
            if constexpr (P::GATHER) vAc[h][i] = S.row_off(cur, h * HALF + Rs[i]) + (unsigned)Cs[i] * 2u;
            else vAc[h][i] = (unsigned)((h * HALF + Rs[i]) * K + Cs[i]) * 2u;
            vAn[h][i] = vAc[h][i];
        }
    const char* cA = cur.a; const char* cB = cur.b;
    PG8_STAGE_B(PG8_SB(0, 0), cB); PG8_STAGE_B(PG8_SB(0, 1), cB + hstep); PG8_STAGE_A(PG8_SA(0, 0), cA, vAc, 0); PG8_STAGE_A(PG8_SA(0, 1), cA, vAc, 1);
    if (wr == 1) PG8_BAR;
    PG8_WAIT_V(2); PG8_BAR;
    PG8_STAGE_B(PG8_SB(1, 0), cB + kstep); PG8_STAGE_A(PG8_SA(1, 0), cA + kstep, vAc, 0); PG8_STAGE_B(PG8_SB(1, 1), cB + hstep + kstep);
    PG8_WAIT_V(6); PG8_BAR;
    for (;;) {
        const bool has_next = S.next(ui + 1, nxt);
        const char* nA = has_next ? nxt.a : cA; const char* nB = has_next ? nxt.b : cB;
        if constexpr (P::GATHER) {
            if (has_next) {
#pragma unroll
                for (int h = 0; h < 2; ++h)
#pragma unroll
                    for (int i = 0; i < 2; ++i) vAn[h][i] = S.row_off(nxt, h * HALF + Rs[i]) + (unsigned)Cs[i] * 2u;
            }
        }
#pragma clang loop unroll(disable)
        for (int t = 0; t < nt; t += 2) {
            const bool last = (t == nt - 2);
            const char* a1 = cA + (size_t)(t + 1) * kstep;
            const char* a2 = last ? nA : cA + (size_t)(t + 2) * kstep; const char* b2 = last ? nB : cB + (size_t)(t + 2) * kstep;
            const char* a3 = a2 + kstep; const char* b3 = b2 + kstep;
            unsigned o2[2][2];
#pragma unroll
            for (int h = 0; h < 2; ++h)
#pragma unroll
                for (int i = 0; i < 2; ++i) o2[h][i] = (P::GATHER && last) ? vAn[h][i] : vAc[h][i];
            PG8_LDB(B0, 0, 0); PG8_LDB(B1, 0, 1); PG8_SCHED; PG8_LDA(At, 0, 0); PG8_STAGE_A(PG8_SA(1, 1), a1, vAc, 1);
            PG8_WAIT_V(8); PG8_WAIT_L(0); PG8_BAR; PG8_MMA(0, 0, At, B0); PG8_MMA(0, 1, At, B1); PG8_BAR; PG8_SCHED;
            PG8_LDA(At, 0, 1); PG8_STAGE_B(PG8_SB(0, 0), b2); PG8_STAGE_B(PG8_SB(0, 1), b2 + hstep); PG8_STAGE_A(PG8_SA(0, 0), a2, o2, 0);
            PG8_WAIT_V(8); PG8_WAIT_L(0); PG8_BAR; PG8_MMA(1, 0, At, B0); PG8_MMA(1, 1, At, B1); PG8_BAR; PG8_SCHED;
            PG8_LDB(B0, 1, 0); PG8_LDB(B1, 1, 1); PG8_SCHED; PG8_LDA(At, 1, 0); PG8_STAGE_A(PG8_SA(0, 1), a2, o2, 1);
            PG8_WAIT_V(8); PG8_WAIT_L(0); PG8_BAR; PG8_MMA(0, 0, At, B0); PG8_MMA(0, 1, At, B1); PG8_BAR; PG8_SCHED;
            PG8_LDA(At, 1, 1); PG8_STAGE_B(PG8_SB(1, 0), b3); PG8_STAGE_B(PG8_SB(1, 1), b3 + hstep); PG8_STAGE_A(PG8_SA(1, 0), a3, o2, 0);
            PG8_WAIT_V(8); PG8_WAIT_L(0); PG8_BAR; PG8_MMA(1, 0, At, B0); PG8_MMA(1, 1, At, B1); PG8_BAR; PG8_SCHED;
        }
        if (wr == 0) PG8_BAR;
        S.epi(acc, cur, wr, wc, fr, fq);
        if (!has_next) break;
#pragma unroll
        for (int a = 0; a < 2; ++a)
#pragma unroll
            for (int b = 0; b < 2; ++b)
#pragma unroll
                for (int m = 0; m < 4; ++m)
#pragma unroll
                    for (int n = 0; n < 2; ++n) acc[a][b][m][n] = (f32x4){0.f, 0.f, 0.f, 0.f};
        cur = nxt; cA = nA; cB = nB; ++ui;
#pragma unroll
        for (int h = 0; h < 2; ++h)
#pragma unroll
            for (int i = 0; i < 2; ++i) vAc[h][i] = vAn[h][i];
        if (wr == 1) PG8_BAR;
    }
    PG8_WAIT_V(0);
    PG8_BAR;
#undef PG8_SA
#undef PG8_SB
#undef PG8_STAGE_A
#undef PG8_STAGE_B
#undef PG8_LDA
#undef PG8_LDB
#undef PG8_MMA
#undef PG8_WAIT_V
#undef PG8_WAIT_L
#undef PG8_BAR
#undef PG8_SCHED
}
}
constexpr size_t MiB = (size_t)1 << 20;
constexpr size_t WS_CTL = 0, CTL_ZERO_BYTES = 1 * MiB;
constexpr size_t WS_BT1 = 2 * MiB;
constexpr size_t WS_BT2 = 16 * MiB;
constexpr size_t WS_WR = 18 * MiB;
constexpr size_t WS_WSB = 19 * MiB;
constexpr size_t WS_BTGU = 20 * MiB;
constexpr size_t WS_BTD = 148 * MiB;
constexpr size_t WS_H = 212 * MiB;
constexpr size_t WS_C = 244 * MiB;
constexpr size_t WS_P = WS_C, WS_Q = WS_C + 32 * MiB, WS_R = WS_C + 64 * MiB, WS_V = WS_C + 96 * MiB;
constexpr size_t WS_H2 = WS_C, WS_HID = WS_C + 32 * MiB, WS_Y = WS_C + 96 * MiB;
constexpr size_t WS_LTOK = 404 * MiB, WS_LW = 408 * MiB, WS_LRS = 412 * MiB;
constexpr size_t WS_X2 = 420 * MiB;
constexpr size_t WS_ROUTE = 416 * MiB;
constexpr size_t WS_DBG = 417 * MiB;
constexpr size_t WS_NEED = 512 * MiB;
constexpr int CW_TMO = 0, CW_GCNT = 1024, CW_STAT = 2048, CW_BAR = 4096;
static_assert((CW_BAR + XCD_BAR_WORDS) * 4 <= (int)CTL_ZERO_BYTES, "ctl");
constexpr int RING_BYTES = 131072;
constexpr int TAB_OFF = RING_BYTES;
constexpr int PS_OFF = TAB_OFF + 4096;
constexpr int CN_OFF = PS_OFF + 320;
constexpr int MISC_OFF = CN_OFF + 256;
constexpr int LDS_BYTES = 147456;
static_assert(MISC_OFF + 16 <= LDS_BYTES, "lds");
constexpr int MAXU = 4;

struct Frame {
    LAS unsigned char* lds; int tid, lane, wave, G, bid;
    unsigned* ctl;
    const float *x, *g_mix, *w_in, *w_s, *b_s, *g_sgu, *w_conv, *w_out, *g_ffn, *w_rg, *w_re, *wg, *wu, *wd, *g_final;
    float* out; float* x2; unsigned char* ws;
};

struct TJob { const float* src; bf16_t* dst; int ld, ldd; };
constexpr int NJ_IN = 16 * 56, NJ_OUT = 16 * 8, NJ_GU = 64 * 16 * 8, NJ_DN = 64 * 8 * 8, NJOBS = NJ_IN + NJ_OUT + NJ_GU + NJ_DN;
__device__ __forceinline__ TJob tjob(const Frame& F, int j) {
    TJob J;
    if (j < NJ_IN) { const int kt = j / 56, nt = j % 56, pn = nt >> 1, bj = nt & 1; int sc;
        if (pn < 8) sc = bj ? 5120 + 128 * pn : 128 * pn;
        else if (pn < 16) sc = bj ? 6144 + 128 * (pn - 8) : 2048 + 128 * (pn - 8);
        else if (pn < 24) sc = bj ? 4096 + 128 * (pn - 16) : 3072 + 128 * (pn - 16);
        else sc = 1024 + 256 * (pn - 24) + 128 * bj;
        J.src = F.w_in + (size_t)(kt * 64) * NP + sc; J.ld = NP; J.dst = (bf16_t*)(F.ws + WS_BT1) + (size_t)(nt * 128) * 1024 + kt * 64; J.ldd = 1024; return J; }
    j -= NJ_IN;
    if (j < NJ_OUT) { const int kt = j / 8, nt = j % 8;
        J.src = F.w_out + (size_t)(kt * 64) * D + nt * 128; J.ld = D; J.dst = (bf16_t*)(F.ws + WS_BT2) + (size_t)(nt * 128) * 1024 + kt * 64; J.ldd = 1024; return J; }
    j -= NJ_OUT;
    if (j < NJ_GU) { const int e = j / 128, r = j % 128, kt = r / 8, nt = r % 8, jj = nt >> 1, bj = nt & 1;
        J.src = (bj ? F.wu : F.wg) + (size_t)e * 1024 * 512 + (size_t)(kt * 64) * 512 + jj * 128; J.ld = 512;
        J.dst = (bf16_t*)(F.ws + WS_BTGU) + ((size_t)e * 1024 + jj * 256 + bj * 128) * 1024 + kt * 64; J.ldd = 1024; return J; }
    j -= NJ_GU;
    { const int e = j / 64, r = j % 64, kt = r / 8, nt = r % 8;
      J.src = F.wd + (size_t)e * 512 * 1024 + (size_t)(kt * 64) * 1024 + nt * 128; J.ld = 1024;
      J.dst = (bf16_t*)(F.ws + WS_BTD) + ((size_t)e * 1024 + nt * 128) * 512 + kt * 64; J.ldd = 512; return J; }
}
__device__ __forceinline__ unsigned off_b(unsigned row, unsigned ch) { return 256u * row + 16u * (ch ^ (((row & 3) << 2) | ((row >> 2) & 3))); }
__device__ __forceinline__ unsigned tr_read_addr_16(unsigned lane, unsigned c, unsigned ks, unsigned t) {
    const unsigned g = lane >> 4, q = (lane & 15) >> 2, p = lane & 3;
    return off_b(32 * ks + 8 * g + 4 * t + q, 2 * c + (p >> 1)) + 8 * (p & 1);
}
__device__ __forceinline__ void convert_jobs(const Frame& F, int jlo, int jhi) {
    LAS float* tile0 = (LAS float*)F.lds;
    const int kr = F.tid >> 5, n4 = (F.tid & 31) * 4;
    f32x4 v0[4], v1[4], v2[4];
#define CJ_LOAD(v, jj) do { if ((jj) < jhi) { const TJob J_ = tjob(F, (jj)); _Pragma("unroll") for (int p = 0; p < 4; ++p) v[p] = __builtin_nontemporal_load((const f32x4*)(J_.src + (size_t)(kr + 16 * p) * J_.ld + n4)); } } while (0)
#define CJ_STEP(v, jj, par) do { if ((jj) < jhi) { const TJob J_ = tjob(F, (jj)); LAS float* tile = tile0 + (par) * (64 * 129); \
        _Pragma("unroll") for (int p = 0; p < 4; ++p) { LAS float* d = tile + (kr + 16 * p) * 129 + n4; d[0] = v[p][0]; d[1] = v[p][1]; d[2] = v[p][2]; d[3] = v[p][3]; } \
        CJ_LOAD(v, (jj) + 3 * F.G); \
        __syncthreads(); \
        _Pragma("unroll") for (int rep = 0; rep < 2; ++rep) { const int n = (F.tid >> 3) + 64 * rep, k8 = (F.tid & 7) * 8; const LAS float* s_ = tile + k8 * 129 + n; \
            u32x4 o; o.x = cvt_pk_bf16(s_[0], s_[129]); o.y = cvt_pk_bf16(s_[2 * 129], s_[3 * 129]); o.z = cvt_pk_bf16(s_[4 * 129], s_[5 * 129]); o.w = cvt_pk_bf16(s_[6 * 129], s_[7 * 129]); \
            *(u32x4*)(J_.dst + (size_t)n * J_.ldd + k8) = o; } } } while (0)
    int j = jlo + F.bid;
    CJ_LOAD(v0, j); CJ_LOAD(v1, j + F.G); CJ_LOAD(v2, j + 2 * F.G);
    for (; j < jhi; j += 6 * F.G) {
        CJ_STEP(v0, j, 0); CJ_STEP(v1, j + F.G, 1); CJ_STEP(v2, j + 2 * F.G, 0);
        CJ_STEP(v0, j + 3 * F.G, 1); CJ_STEP(v1, j + 4 * F.G, 0); CJ_STEP(v2, j + 5 * F.G, 1);
    }
    __syncthreads();
#undef CJ_LOAD
#undef CJ_STEP
}
constexpr int NI_GU = 64 * 16 * 32, NI_DN = 64 * 8 * 32, NITEMS_X = NI_GU + NI_DN;
__device__ __forceinline__ void xitem(const Frame& F, int id, const float*& src, int& ld, bf16_t*& dst, int& ldd) {
    if (id < NI_GU) { const int e = id >> 9, r = id & 511, kt = r >> 5, nb = r & 31, jj = nb >> 3, bj = (nb >> 2) & 1, sub = nb & 3;
        src = (bj ? F.wu : F.wg) + (size_t)e * 1024 * 512 + (size_t)(kt * 64) * 512 + jj * 128 + sub * 32; ld = 512;
        dst = (bf16_t*)(F.ws + WS_BTGU) + ((size_t)e * 1024 + nb * 32) * 1024 + kt * 64; ldd = 1024; }
    else { id -= NI_GU; const int e = id >> 8, r = id & 255, kt = r >> 5, nb = r & 31;
        src = F.wd + (size_t)e * 512 * 1024 + (size_t)(kt * 64) * 1024 + nb * 32; ld = 1024;
        dst = (bf16_t*)(F.ws + WS_BTD) + ((size_t)e * 1024 + nb * 32) * 512 + kt * 64; ldd = 512; }
}
__device__ __forceinline__ void convert_experts_wave(const Frame& F) {
    LAS float* scr = (LAS float*)(F.lds + F.wave * 8448);
    const int gw = F.bid * NWAVES + F.wave, NGW = F.G * NWAVES;
    const int lk = F.lane >> 5, ln = F.lane & 31;
    const int c8 = F.lane & 7, nr = F.lane >> 3;
    float va[32], vb[32], vc[32];
#define XI_LOAD(v, id) do { if ((id) < NITEMS_X) { const float* s_; int ld_; bf16_t* d_; int ldd_; xitem(F, (id), s_, ld_, d_, ldd_); \
        _Pragma("unroll") for (int i = 0; i < 32; ++i) v[i] = __builtin_nontemporal_load(s_ + (size_t)(2 * i + lk) * ld_ + ln); } } while (0)
#define XI_STEP(v, id) do { if ((id) < NITEMS_X) { const float* s_; int ld_; bf16_t* d_; int ldd_; xitem(F, (id), s_, ld_, d_, ldd_); \
        _Pragma("unroll") for (int i = 0; i < 32; ++i) scr[(2 * i + lk) * 33 + ln] = v[i]; \
        XI_LOAD(v, (id) + 3 * NGW); \
        _Pragma("unroll") for (int j = 0; j < 4; ++j) { const int n = nr + 8 * j; const LAS float* t_ = scr + (8 * c8) * 33 + n; \
            u32x4 o; o.x = cvt_pk_bf16(t_[0], t_[33]); o.y = cvt_pk_bf16(t_[2 * 33], t_[3 * 33]); o.z = cvt_pk_bf16(t_[4 * 33], t_[5 * 33]); o.w = cvt_pk_bf16(t_[6 * 33], t_[7 * 33]); \
            *(u32x4*)(d_ + (size_t)n * ldd_ + 8 * c8) = o; } } } while (0)
    int id = gw;
    XI_LOAD(va, id); XI_LOAD(vb, id + NGW); XI_LOAD(vc, id + 2 * NGW);
    for (; id < NITEMS_X; id += 3 * NGW) { XI_STEP(va, id); XI_STEP(vb, id + NGW); XI_STEP(vc, id + 2 * NGW); }
#undef XI_LOAD
#undef XI_STEP
    __syncthreads();
}
__device__ __forceinline__ void phase_prologue(const Frame& F) {
    convert_jobs(F, 0, NJ_IN + NJ_OUT);
    { bf16_t* hi = (bf16_t*)(F.ws + WS_WR); bf16_t* lo = hi + 80 * 1024;
      for (int i = F.bid * NTHR + F.tid; i < 80 * 1024; i += F.G * NTHR) { const int jj = i >> 10, c = i & 1023;
          float w = 0.f; if (jj < 64) w = F.w_re[c * 64 + jj] * F.g_ffn[c]; else if (jj < 72) w = F.w_rg[c * 8 + (jj - 64)] * F.g_ffn[c];
          const unsigned h = cvt_pk_bf16(w, 0.f) & 0xffffu; const float r = w - __uint_as_float(h << 16);
          hi[i] = (bf16_t)h; lo[i] = (bf16_t)(cvt_pk_bf16(r, 0.f) & 0xffffu); } }
    { bf16_t* o = (bf16_t*)(F.ws + WS_WSB);
      for (int i = F.bid * NTHR + F.tid; i < 8 * 128 * 128; i += F.G * NTHR) o[i] = (bf16_t)(cvt_pk_bf16(F.w_s[i], 0.f) & 0xffffu); }
    { bf16_t* H = (bf16_t*)(F.ws + WS_H);
      f32x4 g[4];
#pragma unroll
      for (int q = 0; q < 4; ++q) g[q] = *(const f32x4*)(F.g_mix + 4 * F.lane + 256 * q);
      for (int row = F.bid * NWAVES + F.wave; row < T; row += F.G * NWAVES) {
          const float* xr = F.x + (size_t)row * D + 4 * F.lane; f32x4 a[4]; float s = 0.f;
#pragma unroll
          for (int q = 0; q < 4; ++q) { a[q] = *(const f32x4*)(xr + 256 * q); s += (a[q][0] * a[q][0] + a[q][1] * a[q][1]) + (a[q][2] * a[q][2] + a[q][3] * a[q][3]); }
          const float r = 1.0f / sqrtf(wave_sum(s) * (1.0f / D) + EPS);
#pragma unroll
          for (int q = 0; q < 4; ++q) { u32x2 o; o.x = cvt_pk_bf16(a[q][0] * r * g[q][0], a[q][1] * r * g[q][1]); o.y = cvt_pk_bf16(a[q][2] * r * g[q][2], a[q][3] * r * g[q][3]);
              *(u32x2*)(H + (size_t)row * D + 4 * F.lane + 256 * q) = o; }
      } }
}

struct ProbProj {
    static constexpr int K = 1024; static constexpr bool PERM = true, GATHER = false;
    const bf16_t* A; const bf16_t* Bt; pg8::StaticOrder so; bf16_t *Pp, *Qp, *Rp, *Vp; int ilo, ihi;
    __device__ __forceinline__ bool next(int i, pg8::Unit& u) const { int pm, pn; if (ilo + i >= ihi || !so.next(ilo + i, pm, pn)) return false; u.m0 = pm; u.n0 = pn; u.e = 0; u.cnt = 0; u.lb = 0;
        u.a = (const char*)A + (size_t)pm * 256 * K * 2; u.b = (const char*)Bt + (size_t)pn * 256 * K * 2; return true; }
    __device__ __forceinline__ unsigned row_off(const pg8::Unit&, int) const { return 0u; }
    __device__ __forceinline__ void epi(const f32x4 (&acc)[2][2][4][2], const pg8::Unit& u, int wr, int wc, int fr, int fq) const {
        const int pn = u.n0, row0 = u.m0 * 256 + wr * 64 + fr, cl = wc * 32 + 8 * fq;
        if (pn < 24) {
            const int ty = pn >> 3; bf16_t* dst = Pp + (size_t)ty * ((32 * MiB) / 2) + (pn & 7) * 128 + cl;
#pragma unroll
            for (int ai = 0; ai < 2; ++ai)
#pragma unroll
                for (int m = 0; m < 4; ++m) {
                    float o[8];
#pragma unroll
                    for (int n = 0; n < 2; ++n)
#pragma unroll
                        for (int q = 0; q < 4; ++q) { const float X = acc[ai][0][m][n][q], Y = acc[ai][1][m][n][q];
                            o[n * 4 + q] = (ty == 0) ? fast_gelu(X) * fast_sigm(Y) : ((ty == 1) ? X * fast_sigm(Y) : X * Y); }
                    u32x4 w; w.x = cvt_pk_bf16(o[0], o[1]); w.y = cvt_pk_bf16(o[2], o[3]); w.z = cvt_pk_bf16(o[4], o[5]); w.w = cvt_pk_bf16(o[6], o[7]);
                    __builtin_nontemporal_store(w, (u32x4*)(dst + (size_t)(row0 + ai * 128 + m * 16) * D)); }
        } else {
            bf16_t* dst = Vp + (pn - 24) * 256 + cl;
#pragma unroll
            for (int ai = 0; ai < 2; ++ai)
#pragma unroll
                for (int m = 0; m < 4; ++m)
#pragma unroll
                    for (int bj = 0; bj < 2; ++bj) {
                        float o[8];
#pragma unroll
                        for (int n = 0; n < 2; ++n)
#pragma unroll
                            for (int q = 0; q < 4; ++q) o[n * 4 + q] = fast_gelu(acc[ai][bj][m][n][q]);
                        u32x4 w; w.x = cvt_pk_bf16(o[0], o[1]); w.y = cvt_pk_bf16(o[2], o[3]); w.z = cvt_pk_bf16(o[4], o[5]); w.w = cvt_pk_bf16(o[6], o[7]);
                        __builtin_nontemporal_store(w, (u32x4*)(dst + (size_t)(row0 + ai * 128 + m * 16) * D + bj * 128)); }
        }
    }
};

__device__ __forceinline__ void phase_sgu(const Frame& F) {
    const bf16_t* Pp = (const bf16_t*)(F.ws + WS_P); const bf16_t* Qp = (const bf16_t*)(F.ws + WS_Q); const bf16_t* Rp = (const bf16_t*)(F.ws + WS_R); const bf16_t* Vp = (const bf16_t*)(F.ws + WS_V);
    const bf16_t* Wsb = (const bf16_t*)(F.ws + WS_WSB); bf16_t* Mg = (bf16_t*)(F.ws + WS_H);
    LAS unsigned char* VT = F.lds;
    LAS float* ZB = (LAS float*)(F.lds + 32768);
    const int ch = F.tid & 15, pr = F.tid >> 4;
    const unsigned vbase = (unsigned)(size_t)VT;
    for (int unit = F.bid; unit < 1024; unit += F.G) {
        const int chunk = unit >> 3, g = unit & 7, t0 = chunk * 128, c0 = g * 128;
        u32x4 pvv[4], qvv[4], r0v[4], rmv[4], rpv[4];
#pragma unroll
        for (int ps = 0; ps < 4; ++ps) { const int t = t0 + pr + 32 * ps; const size_t o = (size_t)t * D + c0 + 8 * ch; const int ts = t & (SEQ - 1);
            pvv[ps] = *(const u32x4*)(Pp + o); qvv[ps] = *(const u32x4*)(Qp + o); r0v[ps] = *(const u32x4*)(Rp + o);
            rmv[ps] = (u32x4){0u, 0u, 0u, 0u}; rpv[ps] = (u32x4){0u, 0u, 0u, 0u};
            if (ts > 0) rmv[ps] = *(const u32x4*)(Rp + o - D);
            if (ts < SEQ - 1) rpv[ps] = *(const u32x4*)(Rp + o + D); }
        float gs[8];
#pragma unroll
        for (int q = 0; q < 2; ++q) { const f32x4 t4 = *(const f32x4*)(F.g_sgu + c0 + 8 * ch + 4 * q); gs[4 * q] = t4[0]; gs[4 * q + 1] = t4[1]; gs[4 * q + 2] = t4[2]; gs[4 * q + 3] = t4[3]; }
#pragma unroll
        for (int ps = 0; ps < 4; ++ps) {
            const int p = pr + 32 * ps;
            const u32x4 raw = *(const u32x4*)(Vp + (size_t)(t0 + p) * D + c0 + 8 * ch);
            float v[8]; v[0] = bf_lo(raw.x); v[1] = bf_hi(raw.x); v[2] = bf_lo(raw.y); v[3] = bf_hi(raw.y); v[4] = bf_lo(raw.z); v[5] = bf_hi(raw.z); v[6] = bf_lo(raw.w); v[7] = bf_hi(raw.w);
            float s = ((v[0] + v[1]) + (v[2] + v[3])) + ((v[4] + v[5]) + (v[6] + v[7]));
            s += __shfl_xor(s, 1); s += __shfl_xor(s, 2); s += __shfl_xor(s, 4); s += __shfl_xor(s, 8);
            const float mean = s * (1.0f / 128.f); float qv = 0.f;
#pragma unroll
            for (int i = 0; i < 8; ++i) { v[i] -= mean; qv += v[i] * v[i]; }
            qv += __shfl_xor(qv, 1); qv += __shfl_xor(qv, 2); qv += __shfl_xor(qv, 4); qv += __shfl_xor(qv, 8);
            const float r = 1.0f / sqrtf(qv * (1.0f / 128.f) + EPS);
            u32x4 o; o.x = cvt_pk_bf16(v[0] * r * gs[0], v[1] * r * gs[1]); o.y = cvt_pk_bf16(v[2] * r * gs[2], v[3] * r * gs[3]);
            o.z = cvt_pk_bf16(v[4] * r * gs[4], v[5] * r * gs[5]); o.w = cvt_pk_bf16(v[6] * r * gs[6], v[7] * r * gs[7]);
            *(LAS u32x4*)(VT + off_b(p, ch)) = o;
        }
        __syncthreads();
        {
            const int q0 = 16 * F.wave; const int l15 = F.lane & 15, lq = F.lane >> 4;
            bf16x8 Yf[4];
#pragma unroll
            for (int ks = 0; ks < 4; ++ks) Yf[ks] = *(const bf16x8*)(Wsb + (size_t)(g * 128 + q0 + l15) * 128 + 32 * ks + 8 * lq);
            const float bq = F.b_s[g * 128 + q0 + l15];
#pragma unroll
            for (int ct = 0; ct < 8; ++ct) {
                const unsigned a0 = vbase + tr_read_addr_16(F.lane, ct, 0, 0), a1 = vbase + tr_read_addr_16(F.lane, ct, 0, 1);
                u16x4 x00, x01, x10, x11, x20, x21, x30, x31;
                asm volatile("ds_read_b64_tr_b16 %0, %8\n\tds_read_b64_tr_b16 %1, %9\n\tds_read_b64_tr_b16 %2, %8 offset:8192\n\tds_read_b64_tr_b16 %3, %9 offset:8192\n\t"
                             "ds_read_b64_tr_b16 %4, %8 offset:16384\n\tds_read_b64_tr_b16 %5, %9 offset:16384\n\tds_read_b64_tr_b16 %6, %8 offset:24576\n\tds_read_b64_tr_b16 %7, %9 offset:24576\n\t"
                             "s_waitcnt lgkmcnt(0)"
                             : "=&v"(x00), "=&v"(x01), "=&v"(x10), "=&v"(x11), "=&v"(x20), "=&v"(x21), "=&v"(x30), "=&v"(x31) : "v"(a0), "v"(a1) : "memory");
                f32x4 acc = (f32x4){0.f, 0.f, 0.f, 0.f};
                bf16x8 X;
                X = (bf16x8){(short)x00[0], (short)x00[1], (short)x00[2], (short)x00[3], (short)x01[0], (short)x01[1], (short)x01[2], (short)x01[3]}; acc = __builtin_amdgcn_mfma_f32_16x16x32_bf16(X, Yf[0], acc, 0, 0, 0);
                X = (bf16x8){(short)x10[0], (short)x10[1], (short)x10[2], (short)x10[3], (short)x11[0], (short)x11[1], (short)x11[2], (short)x11[3]}; acc = __builtin_amdgcn_mfma_f32_16x16x32_bf16(X, Yf[1], acc, 0, 0, 0);
                X = (bf16x8){(short)x20[0], (short)x20[1], (short)x20[2], (short)x20[3], (short)x21[0], (short)x21[1], (short)x21[2], (short)x21[3]}; acc = __builtin_amdgcn_mfma_f32_16x16x32_bf16(X, Yf[2], acc, 0, 0, 0);
                X = (bf16x8){(short)x30[0], (short)x30[1], (short)x30[2], (short)x30[3], (short)x31[0], (short)x31[1], (short)x31[2], (short)x31[3]}; acc = __builtin_amdgcn_mfma_f32_16x16x32_bf16(X, Yf[3], acc, 0, 0, 0);
                acc = acc + bq;
                *(LAS f32x4*)(ZB + (q0 + l15) * 132 + 16 * ct + 4 * lq) = acc;
            }
        }
        __syncthreads();
        {
            float w0[8], w1[8], w2[8];
#pragma unroll
            for (int q = 0; q < 2; ++q) { const f32x4 a = *(const f32x4*)(F.w_conv + c0 + 8 * ch + 4 * q), b = *(const f32x4*)(F.w_conv + 1024 + c0 + 8 * ch + 4 * q), c = *(const f32x4*)(F.w_conv + 2048 + c0 + 8 * ch + 4 * q);
#pragma unroll
                for (int i = 0; i < 4; ++i) { w0[4 * q + i] = a[i]; w1[4 * q + i] = b[i]; w2[4 * q + i] = c[i]; } }
#pragma unroll
            for (int ps = 0; ps < 4; ++ps) {
                const int q = pr + 32 * ps, t = t0 + q; const size_t o = (size_t)t * D + c0 + 8 * ch;
                const u32x4 pv = pvv[ps], qv = qvv[ps], r0 = r0v[ps], rm = rmv[ps], rp = rpv[ps];
                const f32x4 z0 = *(const LAS f32x4*)(ZB + q * 132 + 8 * ch), z1 = *(const LAS f32x4*)(ZB + q * 132 + 8 * ch + 4);
                float zz[8] = {z0[0], z0[1], z0[2], z0[3], z1[0], z1[1], z1[2], z1[3]};
                float res[8];
#pragma unroll
                for (int i = 0; i < 4; ++i) {
                    const unsigned pw = pv[i], qw = qv[i], rmw = rm[i], r0w = r0[i], rpw = rp[i];
                    res[2 * i] = bf_lo(pw) * zz[2 * i] + bf_lo(qw) * (w0[2 * i] * bf_lo(rmw) + w1[2 * i] * bf_lo(r0w) + w2[2 * i] * bf_lo(rpw));
                    res[2 * i + 1] = bf_hi(pw) * zz[2 * i + 1] + bf_hi(qw) * (w0[2 * i + 1] * bf_hi(rmw) + w1[2 * i + 1] * bf_hi(r0w) + w2[2 * i + 1] * bf_hi(rpw));
                }
                u32x4 w; w.x = cvt_pk_bf16(res[0], res[1]); w.y = cvt_pk_bf16(res[2], res[3]); w.z = cvt_pk_bf16(res[4], res[5]); w.w = cvt_pk_bf16(res[6], res[7]);
                *(u32x4*)(Mg + o) = w;
            }
        }
        __syncthreads();
    }
}

struct ProbOut {
    static constexpr int K = 1024; static constexpr bool PERM = true, GATHER = false;
    const bf16_t* A; const bf16_t* Bt; pg8::StaticOrder so; const float* x; const float* gf; float* X2; bf16_t* H2;
    __device__ __forceinline__ bool next(int i, pg8::Unit& u) const { int pm, pn; if (!so.next(i, pm, pn)) return false; u.m0 = pm; u.n0 = pn; u.e = 0; u.cnt = 0; u.lb = 0;
        u.a = (const char*)A + (size_t)pm * 256 * K * 2; u.b = (const char*)Bt + (size_t)pn * 256 * K * 2; return true; }
    __device__ __forceinline__ unsigned row_off(const pg8::Unit&, int) const { return 0u; }
    __device__ __forceinline__ void epi(const f32x4 (&acc)[2][2][4][2], const pg8::Unit& u, int wr, int wc, int fr, int fq) const {
        const int row0 = u.m0 * 256 + wr * 64 + fr, col0 = u.n0 * 256 + wc * 32 + 8 * fq;
#pragma unroll
        for (int bj = 0; bj < 2; ++bj) {
            const int col = col0 + bj * 128;
            const f32x4 g0 = *(const f32x4*)(gf + col), g1 = *(const f32x4*)(gf + col + 4);
#pragma unroll
            for (int ai = 0; ai < 2; ++ai)
#pragma unroll
                for (int m = 0; m < 4; ++m) {
                    const size_t o = (size_t)(row0 + ai * 128 + m * 16) * D + col;
                    const f32x4 o0 = acc[ai][bj][m][0] + *(const f32x4*)(x + o), o1 = acc[ai][bj][m][1] + *(const f32x4*)(x + o + 4);
                    *(f32x4*)(X2 + o) = o0; *(f32x4*)(X2 + o + 4) = o1;
                    u32x4 w; w.x = cvt_pk_bf16(o0[0] * g0[0], o0[1] * g0[1]); w.y = cvt_pk_bf16(o0[2] * g0[2], o0[3] * g0[3]); w.z = cvt_pk_bf16(o1[0] * g1[0], o1[1] * g1[1]); w.w = cvt_pk_bf16(o1[2] * g1[2], o1[3] * g1[3]);
                    *(u32x4*)(H2 + o) = w;
                }
        }
    }
};

__device__ __forceinline__ void phase_router(const Frame& F) {
    const float* X2 = F.x2; const bf16_t* WRh = (const bf16_t*)(F.ws + WS_WR);
    int* ltok = (int*)(F.ws + WS_LTOK); float* lw = (float*)(F.ws + WS_LW); float* lrs = (float*)(F.ws + WS_LRS); float* route = (float*)(F.ws + WS_ROUTE);
    unsigned* gcnt = F.ctl + CW_GCNT;
    constexpr int WROW = 528, WMAT = 80 * WROW;
    LAS unsigned char* WL = F.lds;
    LAS float* LG = (LAS float*)(F.lds + 86016);
    LAS float* SS = (LAS float*)(F.lds + 86016 + 40960);
    LAS int* hist = (LAS int*)(F.lds + 86016 + 40960 + 512);
    LAS int* base = hist + 64;
    const int tg = F.wave & 3, kh = F.wave >> 2, l15 = F.lane & 15, lq = F.lane >> 4;
    int wsrc[10], wdst[10];
#pragma unroll
    for (int i = 0; i < 10; ++i) { const int cid = F.tid + 512 * i, mat = cid / 2560, r = (cid % 2560) >> 5, cc = cid & 31; wsrc[i] = (mat * 80 + r) * 1024 + 8 * cc; wdst[i] = mat * WMAT + r * WROW + 16 * cc; }
    for (int unit = F.bid; unit < T / 64; unit += F.G) {
        const int tokw = unit * 64 + tg * 16 + l15;
        const float* xr = X2 + (size_t)tokw * D + kh * 128 + lq * 8;
        f32x4 acc[5];
#pragma unroll
        for (int n = 0; n < 5; ++n) acc[n] = (f32x4){0.f, 0.f, 0.f, 0.f};
        float ssq = 0.f;
        u32x4 wreg[10]; f32x4 xa[8], xb[8];
#define RT_LOAD(q, xv) do { _Pragma("unroll") for (int i = 0; i < 10; ++i) wreg[i] = *(const u32x4*)(WRh + wsrc[i] + 256 * (q)); \
        _Pragma("unroll") for (int ks = 0; ks < 4; ++ks) { xv[2 * ks] = *(const f32x4*)(xr + 256 * (q) + 32 * ks); xv[2 * ks + 1] = *(const f32x4*)(xr + 256 * (q) + 32 * ks + 4); } } while (0)
#define RT_COMPUTE(xv) do { _Pragma("unroll") for (int ks = 0; ks < 4; ++ks) { const f32x4 a0 = xv[2 * ks], a1 = xv[2 * ks + 1]; \
        ssq += (a0[0] * a0[0] + a0[1] * a0[1]) + (a0[2] * a0[2] + a0[3] * a0[3]) + (a1[0] * a1[0] + a1[1] * a1[1]) + (a1[2] * a1[2] + a1[3] * a1[3]); \
        u32x4 hw; hw.x = cvt_pk_bf16(a0[0], a0[1]); hw.y = cvt_pk_bf16(a0[2], a0[3]); hw.z = cvt_pk_bf16(a1[0], a1[1]); hw.w = cvt_pk_bf16(a1[2], a1[3]); \
        u32x4 lw4; lw4.x = cvt_pk_bf16(a0[0] - bf_lo(hw.x), a0[1] - bf_hi(hw.x)); lw4.y = cvt_pk_bf16(a0[2] - bf_lo(hw.y), a0[3] - bf_hi(hw.y)); \
        lw4.z = cvt_pk_bf16(a1[0] - bf_lo(hw.z), a1[1] - bf_hi(hw.z)); lw4.w = cvt_pk_bf16(a1[2] - bf_lo(hw.w), a1[3] - bf_hi(hw.w)); \
        const bf16x8 Ah = __builtin_bit_cast(bf16x8, hw), Al = __builtin_bit_cast(bf16x8, lw4); \
        _Pragma("unroll") for (int n = 0; n < 5; ++n) { const LAS unsigned char* bp = WL + (16 * n + l15) * WROW + (kh * 128 + ks * 32 + lq * 8) * 2; \
            const bf16x8 Bh = *(const LAS bf16x8*)bp, Bl = *(const LAS bf16x8*)(bp + WMAT); \
            acc[n] = __builtin_amdgcn_mfma_f32_16x16x32_bf16(Ah, Bh, acc[n], 0, 0, 0); acc[n] = __builtin_amdgcn_mfma_f32_16x16x32_bf16(Al, Bh, acc[n], 0, 0, 0); \
            acc[n] = __builtin_amdgcn_mfma_f32_16x16x32_bf16(Ah, Bl, acc[n], 0, 0, 0); } } } while (0)
#define RT_STAGE() do { __syncthreads(); _Pragma("unroll") for (int i = 0; i < 10; ++i) *(LAS u32x4*)(WL + wdst[i]) = wreg[i]; } while (0)
        RT_LOAD(0, xa);
        RT_STAGE(); RT_LOAD(1, xb); __syncthreads(); RT_COMPUTE(xa);
        RT_STAGE(); RT_LOAD(2, xa); __syncthreads(); RT_COMPUTE(xb);
        RT_STAGE(); RT_LOAD(3, xb); __syncthreads(); RT_COMPUTE(xa);
        RT_STAGE(); __syncthreads(); RT_COMPUTE(xb);
#undef RT_LOAD
#undef RT_COMPUTE
#undef RT_STAGE
        ssq += __shfl_xor(ssq, 16); ssq += __shfl_xor(ssq, 32);
#pragma unroll
        for (int n = 0; n < 5; ++n)
#pragma unroll
            for (int r = 0; r < 4; ++r) LG[((kh * 4 + tg) * 16 + 4 * lq + r) * 80 + 16 * n + l15] = acc[n][r];
        if (F.lane < 16) SS[(kh * 4 + tg) * 16 + F.lane] = ssq;
        if (F.tid < 64) hist[F.tid] = 0;
        __syncthreads();
        int e0 = 0, e1 = 0, lp0 = 0, lp1 = 0; float w0 = 0.f, w1 = 0.f, rstd = 0.f;
        if (F.tid < 64) {
            const int tgi = F.tid >> 4, i = F.tid & 15;
            const float ss = SS[tgi * 16 + i] + SS[(4 + tgi) * 16 + i]; rstd = 1.0f / sqrtf(ss * (1.0f / D) + EPS);
            const LAS float* l0 = LG + (tgi * 16 + i) * 80; const LAS float* l1 = LG + ((4 + tgi) * 16 + i) * 80;
            int gi = 0; float gm = (l0[64] + l1[64]) * rstd;
#pragma unroll
            for (int j = 1; j < 8; ++j) { const float v = (l0[64 + j] + l1[64 + j]) * rstd; if (v > gm) { gm = v; gi = j; } }
            float den = 0.f;
#pragma unroll
            for (int j = 0; j < 8; ++j) den += __expf((l0[64 + j] + l1[64 + j]) * rstd - gm);
            const float pg = 1.0f / den;
            const LAS float* e0p = l0 + gi * 8; const LAS float* e1p = l1 + gi * 8;
            int i1 = 0; float m1 = (e0p[0] + e1p[0]) * rstd;
#pragma unroll
            for (int j = 1; j < 8; ++j) { const float v = (e0p[j] + e1p[j]) * rstd; if (v > m1) { m1 = v; i1 = j; } }
            int i2 = -1; float m2 = 0.f;
#pragma unroll
            for (int j = 0; j < 8; ++j) { const float v = (e0p[j] + e1p[j]) * rstd; if (j != i1 && (i2 < 0 || v > m2)) { m2 = v; i2 = j; } }
            const float ex = __expf(m2 - m1);
            e0 = gi * 8 + i1; e1 = gi * 8 + i2; w0 = pg / (1.0f + ex); w1 = pg * ex / (1.0f + ex);
            lp0 = __hip_atomic_fetch_add(hist + e0, 1, __ATOMIC_RELAXED, __HIP_MEMORY_SCOPE_WORKGROUP);
            lp1 = __hip_atomic_fetch_add(hist + e1, 1, __ATOMIC_RELAXED, __HIP_MEMORY_SCOPE_WORKGROUP);
        }
        __syncthreads();
        if (F.tid < 64) { const int hc = hist[F.tid]; base[F.tid] = hc ? (int)__hip_atomic_fetch_add(gcnt + F.tid, (unsigned)hc, RLX_AGENT) : 0; }
        __syncthreads();
        if (F.tid < 64) {
            const int t = unit * 64 + F.tid;
            const int p0 = base[e0] + lp0, p1 = base[e1] + lp1;
            ltok[e0 * LCAP + p0] = 2 * t; lw[e0 * LCAP + p0] = w0; lrs[e0 * LCAP + p0] = rstd;
            ltok[e1 * LCAP + p1] = 2 * t + 1; lw[e1 * LCAP + p1] = w1; lrs[e1 * LCAP + p1] = rstd;
            *(f32x4*)(route + (size_t)t * 4) = (f32x4){(float)e0, (float)e1, w0, w1};
        }
        __syncthreads();
    }
}

__device__ __forceinline__ void moe_tables(const Frame& F) {
    LAS int* ps = (LAS int*)(F.lds + PS_OFF); LAS int* cn = (LAS int*)(F.lds + CN_OFF);
    if (F.tid < 64) {
        const int c = (int)__hip_atomic_load(F.ctl + CW_GCNT + F.tid, RLX_AGENT); cn[F.tid] = c;
        int nb = (c + 255) >> 8, incl = nb;
#pragma unroll
        for (int o = 1; o < 64; o <<= 1) { const int v = __shfl_up(incl, o); if (F.lane >= o) incl += v; }
        ps[F.tid] = incl - nb; if (F.tid == 63) ps[64] = incl;
    }
    __syncthreads();
}
struct MoeOrder {
    LAS const int* ps; LAS const int* cn; int nunits, G, c;
    __device__ __forceinline__ bool locate(int i, int& blk, int& j, int& e, int& bin) const {
        const int L = i * G + c; if (L >= nunits) return false;
        const int id = pg8::xcd_remap(L, nunits); blk = id >> 2; j = id & 3;
        const int lane = threadIdx.x & 63;
        const unsigned long long m = __ballot(ps[lane] <= blk);
        e = __builtin_amdgcn_readfirstlane(__builtin_popcountll(m) - 1); bin = blk - ps[e]; return true;
    }
};
struct ProbGU {
    static constexpr int K = 1024; static constexpr bool PERM = true, GATHER = true;
    const bf16_t* H2; const bf16_t* Bt; bf16_t* HID; const float* lrs; LAS const int* tab; MoeOrder mo;
    __device__ __forceinline__ bool next(int i, pg8::Unit& u) const { int blk, j, e, bin; if (!mo.locate(i, blk, j, e, bin)) return false;
        u.m0 = blk; u.n0 = j; u.e = i; u.cnt = mo.cn[e] - bin * 256; u.lb = e * LCAP + bin * 256;
        u.a = (const char*)H2; u.b = (const char*)Bt + ((size_t)e * 1024 + j * 256) * K * 2; return true; }
    __device__ __forceinline__ unsigned row_off(const pg8::Unit& u, int r) const { return (unsigned)tab[u.e * 256 + r] * (unsigned)(K * 2); }
    __device__ __forceinline__ void epi(const f32x4 (&acc)[2][2][4][2], const pg8::Unit& u, int wr, int wc, int fr, int fq) const {
        const int hc = u.n0 * 128 + wc * 32 + 8 * fq;
#pragma unroll
        for (int ai = 0; ai < 2; ++ai)
#pragma unroll
            for (int m = 0; m < 4; ++m) {
                const int rl = ai * 128 + wr * 64 + m * 16 + fr; const int idx = rl < u.cnt ? rl : u.cnt - 1;
                const float rs = lrs[u.lb + idx];
                float o[8];
#pragma unroll
                for (int n = 0; n < 2; ++n)
#pragma unroll
                    for (int q = 0; q < 4; ++q) { const float gt = acc[ai][0][m][n][q] * rs, up = acc[ai][1][m][n][q] * rs; o[n * 4 + q] = gt * fast_sigm(gt) * up; }
                u32x4 w; w.x = cvt_pk_bf16(o[0], o[1]); w.y = cvt_pk_bf16(o[2], o[3]); w.z = cvt_pk_bf16(o[4], o[5]); w.w = cvt_pk_bf16(o[6], o[7]);
                *(u32x4*)(HID + (size_t)(u.m0 * 256 + rl) * DE + hc) = w;
            }
    }
};
struct ProbDown {
    static constexpr int K = 512; static constexpr bool PERM = true, GATHER = false;
    const bf16_t* HID; const bf16_t* Bt; bf16_t* Y; const int* ltok; const float* lw; MoeOrder mo;
    __device__ __forceinline__ bool next(int i, pg8::Unit& u) const { int blk, j, e, bin; if (!mo.locate(i, blk, j, e, bin)) return false;
        u.m0 = blk; u.n0 = j; u.e = e; u.cnt = mo.cn[e] - bin * 256; u.lb = e * LCAP + bin * 256;
        u.a = (const char*)HID + (size_t)blk * 256 * K * 2; u.b = (const char*)Bt + ((size_t)e * 1024 + j * 256) * K * 2; return true; }
    __device__ __forceinline__ unsigned row_off(const pg8::Unit&, int) const { return 0u; }
    __device__ __forceinline__ void epi(const f32x4 (&acc)[2][2][4][2], const pg8::Unit& u, int wr, int wc, int fr, int fq) const {
        const int col0 = u.n0 * 256 + wc * 32 + 8 * fq;
#pragma unroll
        for (int ai = 0; ai < 2; ++ai)
#pragma unroll
            for (int m = 0; m < 4; ++m) {
                const int rl = ai * 128 + wr * 64 + m * 16 + fr; const bool ok = rl < u.cnt; const int idx = ok ? rl : 0;
                const int tk = ltok[u.lb + idx]; const float w = lw[u.lb + idx];
                if (ok) {
#pragma unroll
                    for (int bj = 0; bj < 2; ++bj) {
                        const f32x4 a = acc[ai][bj][m][0] * w, b = acc[ai][bj][m][1] * w;
                        u32x4 o; o.x = cvt_pk_bf16(a[0], a[1]); o.y = cvt_pk_bf16(a[2], a[3]); o.z = cvt_pk_bf16(b[0], b[1]); o.w = cvt_pk_bf16(b[2], b[3]);
                        *(u32x4*)(Y + (size_t)tk * D + col0 + bj * 128) = o; }
                }
            }
    }
};
__device__ __forceinline__ void phase_moe_gu(const Frame& F) {
    moe_tables(F);
    LAS const int* ps = (LAS const int*)(F.lds + PS_OFF); LAS const int* cn = (LAS const int*)(F.lds + CN_OFF); LAS int* tab = (LAS int*)(F.lds + TAB_OFF);
    const int* ltok = (const int*)(F.ws + WS_LTOK);
    ProbGU P; P.H2 = (const bf16_t*)(F.ws + WS_H2); P.Bt = (const bf16_t*)(F.ws + WS_BTGU); P.HID = (bf16_t*)(F.ws + WS_HID); P.lrs = (const float*)(F.ws + WS_LRS); P.tab = tab;
    P.mo.ps = ps; P.mo.cn = cn; P.mo.nunits = ps[64] * 4; P.mo.G = F.G; P.mo.c = F.bid;
    for (int i = 0; i < MAXU; ++i) { int blk, j, e, bin; if (!P.mo.locate(i, blk, j, e, bin)) break;
        const int cnt = cn[e] - bin * 256;
        if (F.tid < 256) { const int idx = F.tid < cnt ? F.tid : cnt - 1; tab[i * 256 + F.tid] = ltok[e * LCAP + bin * 256 + idx] >> 1; } }
    __syncthreads();
    pg8::gemm_phase<ProbGU>(F.lds, P);
}
__device__ __forceinline__ void phase_moe_down(const Frame& F) {
    moe_tables(F);
    LAS const int* ps = (LAS const int*)(F.lds + PS_OFF); LAS const int* cn = (LAS const int*)(F.lds + CN_OFF);
    ProbDown P; P.HID = (const bf16_t*)(F.ws + WS_HID); P.Bt = (const bf16_t*)(F.ws + WS_BTD); P.Y = (bf16_t*)(F.ws + WS_Y); P.ltok = (const int*)(F.ws + WS_LTOK); P.lw = (const float*)(F.ws + WS_LW);
    P.mo.ps = ps; P.mo.cn = cn; P.mo.nunits = ps[64] * 4; P.mo.G = F.G; P.mo.c = F.bid;
    pg8::gemm_phase<ProbDown>(F.lds, P);
}

__device__ __forceinline__ void phase_final(const Frame& F) {
    const bf16_t* Y = (const bf16_t*)(F.ws + WS_Y);
    f32x4 g[4];
#pragma unroll
    for (int q = 0; q < 4; ++q) g[q] = *(const f32x4*)(F.g_final + 4 * F.lane + 256 * q);
    for (int row = F.bid * NWAVES + F.wave; row < T; row += F.G * NWAVES) {
        const float* xr = F.x2 + (size_t)row * D + 4 * F.lane; float* orow = F.out + (size_t)row * D + 4 * F.lane; const bf16_t* y0 = Y + (size_t)(2 * row) * D + 4 * F.lane; const bf16_t* y1 = y0 + D;
        f32x4 a[4]; float s = 0.f;
#pragma unroll
        for (int q = 0; q < 4; ++q) { a[q] = *(const f32x4*)(xr + 256 * q); const u32x2 u0 = *(const u32x2*)(y0 + 256 * q), u1 = *(const u32x2*)(y1 + 256 * q);
            a[q][0] += bf_lo(u0.x) + bf_lo(u1.x); a[q][1] += bf_hi(u0.x) + bf_hi(u1.x); a[q][2] += bf_lo(u0.y) + bf_lo(u1.y); a[q][3] += bf_hi(u0.y) + bf_hi(u1.y);
            s += (a[q][0] * a[q][0] + a[q][1] * a[q][1]) + (a[q][2] * a[q][2] + a[q][3] * a[q][3]); }
        const float r = 1.0f / sqrtf(wave_sum(s) * (1.0f / D) + EPS);
#pragma unroll
        for (int q = 0; q < 4; ++q) *(f32x4*)(orow + 256 * q) = a[q] * r * g[q];
    }
}
constexpr int NPHASES = 8;
struct Args { const float* in[15]; float* out; unsigned char* ws; int ph_lo, ph_hi; };
__global__ void __launch_bounds__(NTHR, 2) fwd_kernel(Args args) {
    extern __shared__ __attribute__((aligned(16))) unsigned char lds_raw[];
    Frame F;
    F.lds = (LAS unsigned char*)lds_raw; F.tid = threadIdx.x; F.lane = F.tid & 63; F.wave = __builtin_amdgcn_readfirstlane(F.tid >> 6); F.G = gridDim.x; F.bid = blockIdx.x;
    F.ws = args.ws; F.ctl = (unsigned*)(args.ws + WS_CTL); F.out = args.out;
#ifndef X2_IN_WS
#define X2_IN_WS 0
#endif
    F.x2 = X2_IN_WS ? (float*)(args.ws + WS_X2) : args.out;
    F.x = args.in[0]; F.g_mix = args.in[1]; F.w_in = args.in[2]; F.w_s = args.in[3]; F.b_s = args.in[4]; F.g_sgu = args.in[5]; F.w_conv = args.in[6]; F.w_out = args.in[7];
    F.g_ffn = args.in[8]; F.w_rg = args.in[9]; F.w_re = args.in[10]; F.wg = args.in[11]; F.wu = args.in[12]; F.wd = args.in[13]; F.g_final = args.in[14];
    if (F.tid < 4) ((LAS unsigned*)(F.lds + MISC_OFF))[F.tid] = 0u;
    __syncthreads();
    const int lo = args.ph_lo, hi = args.ph_hi;
    const bool multi = (hi - lo) > 1;
    XcdBarrier bar; bar.bar = F.ctl + CW_BAR; bar.x = 0; bar.st = nullptr;
    if (multi) bar = xcd_barrier_post(F.ctl + CW_BAR, (volatile LAS unsigned*)(F.lds + MISC_OFF));
#define IN(k) (lo <= (k) && (k) < hi)
#ifndef PROBE_DOUBLE_BAR
#define PROBE_DOUBLE_BAR 0
#endif
#define SEAM(k) do { if (IN(k) && IN((k) + 1)) { xcd_barrier(bar); if (PROBE_DOUBLE_BAR) xcd_barrier(bar); } } while (0)
    if (IN(0)) { phase_prologue(F); } SEAM(0);
    if (IN(1)) {
        ProbProj P; P.A = (const bf16_t*)(F.ws + WS_H); P.Bt = (const bf16_t*)(F.ws + WS_BT1); P.so.init(T, NP, F.G, F.bid);
        P.Pp = (bf16_t*)(F.ws + WS_P); P.Qp = (bf16_t*)(F.ws + WS_Q); P.Rp = (bf16_t*)(F.ws + WS_R); P.Vp = (bf16_t*)(F.ws + WS_V);
        const int nper = (P.so.nwg + F.G - 1) / F.G; int split = 2 * (((F.bid >> 3) & 7) >> 1); if (split > nper) split = nper;
        if (split > 0) { P.ilo = 0; P.ihi = split; pg8::gemm_phase<ProbProj>(F.lds, P); }
        convert_experts_wave(F);
        if (split < nper) { P.ilo = split; P.ihi = nper; pg8::gemm_phase<ProbProj>(F.lds, P); }
    } SEAM(1);
    if (IN(2)) { phase_sgu(F); } SEAM(2);
    if (IN(3)) { ProbOut P; P.A = (const bf16_t*)(F.ws + WS_H); P.Bt = (const bf16_t*)(F.ws + WS_BT2); P.so.init(T, D, F.G, F.bid); P.x = F.x; P.gf = F.g_ffn; P.X2 = F.x2; P.H2 = (bf16_t*)(F.ws + WS_H2);
        pg8::gemm_phase<ProbOut>(F.lds, P); } SEAM(3);
    if (IN(4)) { phase_router(F); } SEAM(4);
    if (IN(5)) { phase_moe_gu(F); } SEAM(5);
    if (IN(6)) { phase_moe_down(F); } SEAM(6);
    if (IN(7)) { phase_final(F); }
#undef IN
#undef SEAM
}

#if DEBUG_CHECK
#ifndef REF_B
#define REF_B 0
#endif
__global__ void cmp_rows(const void* a, int a_bf16, const float* ref, int rows, float* stat) {
    float d2 = 0.f, r2 = 0.f;
    for (size_t i = (size_t)blockIdx.x * blockDim.x + threadIdx.x; i < (size_t)rows * 1024; i += (size_t)gridDim.x * blockDim.x) {
        const float av = a_bf16 ? __uint_as_float(((unsigned)((const bf16_t*)a)[i]) << 16) : ((const float*)a)[i]; const float rv = ref[i];
        const float d = av - rv; d2 += (d == d) ? d * d : 1e30f; r2 += rv * rv; }
    d2 = wave_sum(d2); r2 = wave_sum(r2);
    if ((threadIdx.x & 63) == 0) { atomicAdd(stat, d2); atomicAdd(stat + 1, r2); }
}
__global__ void cmp_pqrv(const bf16_t* Pp, const bf16_t* Qp, const bf16_t* Rp, const bf16_t* Vp, const float* proj, float* stat) {
    float d2[4] = {0.f, 0.f, 0.f, 0.f}, r2[4] = {0.f, 0.f, 0.f, 0.f};
    for (size_t i = (size_t)blockIdx.x * blockDim.x + threadIdx.x; i < (size_t)2048 * 1024; i += (size_t)gridDim.x * blockDim.x) {
        const size_t t = i >> 10; const int c = (int)(i & 1023); const float* pr = proj + t * 7168;
        const float rf[4] = {nv::gelu_t(pr[c]) * nv::sigm(pr[5120 + c]), pr[2048 + c] * nv::sigm(pr[6144 + c]), pr[3072 + c] * pr[4096 + c], nv::gelu_t(pr[1024 + c])};
        const float av[4] = {__uint_as_float(((unsigned)Pp[i]) << 16), __uint_as_float(((unsigned)Qp[i]) << 16), __uint_as_float(((unsigned)Rp[i]) << 16), __uint_as_float(((unsigned)Vp[i]) << 16)};
#pragma unroll
        for (int k = 0; k < 4; ++k) { const float d = av[k] - rf[k]; d2[k] += (d == d) ? d * d : 1e30f; r2[k] += rf[k] * rf[k]; } }
#pragma unroll
    for (int k = 0; k < 4; ++k) { const float a = wave_sum(d2[k]), b = wave_sum(r2[k]); if ((threadIdx.x & 63) == 0) { atomicAdd(stat + 2 * k, a); atomicAdd(stat + 2 * k + 1, b); } }
}
__global__ void cmp_route(const float* mine, const float* ref, float* stat) {
    const int t = blockIdx.x * blockDim.x + threadIdx.x; if (t >= 2048) return;
    const float a0 = mine[t * 4], a1 = mine[t * 4 + 1], b0 = ref[t * 4], b1 = ref[t * 4 + 1];
    const bool same = (a0 == b0 && a1 == b1) || (a0 == b1 && a1 == b0);
    float gd = 0.f; if (same) { const float w0 = (a0 == b0) ? ref[t * 4 + 2] : ref[t * 4 + 3], w1 = (a0 == b0) ? ref[t * 4 + 3] : ref[t * 4 + 2]; gd = fabsf(mine[t * 4 + 2] - w0) + fabsf(mine[t * 4 + 3] - w1); }
    atomicAdd(stat, same ? 0.f : 1.f); atomicAdd(stat + 1, 0.03f);
    atomicAdd(stat + 2, gd); atomicAdd(stat + 3, 1.0f);
}
__global__ void verdict(float* out, const float* stat, int nstage, size_t n) {
    int bad = 0;
    for (int k = 0; k < nstage; ++k) { const float d = stat[2 * k], r = stat[2 * k + 1]; float tol = 1e-3f; if (k == 7) tol = 1.0f;
        if (!(d <= tol * r)) { bad = k + 1; break; } }
    if (!bad) return;
    for (size_t i = (size_t)blockIdx.x * blockDim.x + threadIdx.x; i < n; i += (size_t)gridDim.x * blockDim.x) out[i] = (float)bad;
}
#endif

extern "C" void kernel_launch(void* const* d_in, const int* in_sizes, int n_in, void* d_out, int out_size, void* d_ws, size_t ws_size, hipStream_t stream) {
    static int grid = 0;
    if (grid == 0) {
        if (n_in != 15 || in_sizes[0] != T * D || out_size != T * D || ws_size < WS_NEED) { fprintf(stderr, "kernel_launch: unexpected problem (n_in %d, in0 %d, out %d, ws %zu)\n", n_in, n_in > 0 ? in_sizes[0] : -1, out_size, ws_size); grid = -1; return; }
        int dev = 0, cus = 0, per_cu = 0;
        if (hipGetDevice(&dev) != hipSuccess || hipDeviceGetAttribute(&cus, hipDeviceAttributeMultiprocessorCount, dev) != hipSuccess) { grid = -1; return; }
        if (hipFuncSetAttribute((const void*)fwd_kernel, hipFuncAttributeMaxDynamicSharedMemorySize, LDS_BYTES) != hipSuccess) { fprintf(stderr, "kernel_launch: hipFuncSetAttribute failed\n"); grid = -1; return; }
        if (hipOccupancyMaxActiveBlocksPerMultiprocessor(&per_cu, (const void*)fwd_kernel, NTHR, LDS_BYTES) != hipSuccess || per_cu < 1) { fprintf(stderr, "kernel_launch: occupancy query says %d\n", per_cu); }
        (void)hipGetLastError();
        grid = cus;
        if (grid != 256) fprintf(stderr, "kernel_launch: note: %d CUs\n", grid);
    }
    if (grid < 0) return;
    (void)hipMemsetAsync((char*)d_ws + WS_CTL, 0, CTL_ZERO_BYTES, stream);
    Args a{};
    for (int i = 0; i < 15; ++i) a.in[i] = (const float*)d_in[i];
    a.out = (float*)d_out; a.ws = (unsigned char*)d_ws;
#if DEBUG_CHECK
    {
        char* ws = (char*)d_ws; float* stat = (float*)(ws + WS_CTL) + CW_STAT;
        nv::Bufs B; B.h = (float*)(ws + WS_DBG); B.proj = (float*)(ws + WS_DBG + 8 * MiB); B.merged = (float*)(ws + WS_DBG + 64 * MiB); B.x2 = (float*)(ws + WS_DBG + 72 * MiB);
        float* nout = (float*)(ws + WS_DBG + 80 * MiB); float* nroute = (float*)(ws + WS_DBG + 88 * MiB);
        nv::run_seq(d_in, REF_B, B, nout, nroute, stream);
        const size_t ro = (size_t)REF_B * 2048 * 1024;
        for (int p = 0; p < NPHASES; ++p) {
            a.ph_lo = p; a.ph_hi = p + 1;
            hipLaunchKernelGGL(fwd_kernel, dim3(grid), dim3(NTHR), LDS_BYTES, stream, a);
            if (p == 0) hipLaunchKernelGGL(cmp_rows, dim3(256), dim3(256), 0, stream, (const void*)((const bf16_t*)(ws + WS_H) + ro), 1, (const float*)B.h, 2048, stat + 0);
            if (p == 1) hipLaunchKernelGGL(cmp_pqrv, dim3(256), dim3(256), 0, stream, (const bf16_t*)(ws + WS_P) + ro, (const bf16_t*)(ws + WS_Q) + ro, (const bf16_t*)(ws + WS_R) + ro, (const bf16_t*)(ws + WS_V) + ro, (const float*)B.proj, stat + 2);
            if (p == 2) hipLaunchKernelGGL(cmp_rows, dim3(256), dim3(256), 0, stream, (const void*)((const bf16_t*)(ws + WS_H) + ro), 1, (const float*)B.merged, 2048, stat + 10);
            if (p == 3) hipLaunchKernelGGL(cmp_rows, dim3(256), dim3(256), 0, stream, (const void*)((const float*)d_out + ro), 0, (const float*)B.x2, 2048, stat + 12);
            if (p == 4) hipLaunchKernelGGL(cmp_route, dim3(8), dim3(256), 0, stream, (const float*)(ws + WS_ROUTE) + (size_t)REF_B * 2048 * 4, (const float*)nroute, stat + 14);
            if (p == 7) hipLaunchKernelGGL(cmp_rows, dim3(256), dim3(256), 0, stream, (const void*)((const float*)d_out + ro), 0, (const float*)nout, 2048, stat + 18);
        }
        hipLaunchKernelGGL(verdict, dim3(256), dim3(256), 0, stream, (float*)d_out, (const float*)stat, 10, (size_t)T * D);
    }
#else
#ifndef N_LAUNCH_PER_PHASE
#define N_LAUNCH_PER_PHASE 1
#endif
#ifndef PROBE_REPEAT
#define PROBE_REPEAT -1
#endif
    if (N_LAUNCH_PER_PHASE) { for (int p = 0; p < NPHASES; ++p) { a.ph_lo = p; a.ph_hi = p + 1; hipLaunchKernelGGL(fwd_kernel, dim3(grid), dim3(NTHR), LDS_BYTES, stream, a);
        if (p == PROBE_REPEAT && p == 4) (void)hipMemsetAsync((char*)d_ws + WS_CTL + CW_GCNT * 4, 0, 256, stream);
        if (p == PROBE_REPEAT) hipLaunchKernelGGL(fwd_kernel, dim3(grid), dim3(NTHR), LDS_BYTES, stream, a); } }
    else { a.ph_lo = 0; a.ph_hi = NPHASES; hipLaunchKernelGGL(fwd_kernel, dim3(grid), dim3(NTHR), LDS_BYTES, stream, a); }
#endif
}
```

```cpp
#include <hip/hip_runtime.h>
#include <cstdio>
#include <cstdint>
#define DEBUG_CHECK 0
#define N_LAUNCH_PER_PHASE 0
#define GAS __attribute__((address_space(1)))
#define LAS __attribute__((address_space(3)))
typedef unsigned short bf16_t;
typedef short bf16x8 __attribute__((ext_vector_type(8)));
typedef float f32x4 __attribute__((ext_vector_type(4)));
typedef float f32x2 __attribute__((ext_vector_type(2)));
typedef unsigned u32x4 __attribute__((ext_vector_type(4)));
typedef unsigned u32x2 __attribute__((ext_vector_type(2)));
typedef unsigned short u16x4 __attribute__((ext_vector_type(4)));

constexpr int T = 16384, D = 1024, NP = 7168, NE = 64, DE = 512, SEQ = 2048, LCAP = 16384;
constexpr float EPS = 1e-6f;
constexpr int NWAVES = 8, NTHR = 512;

#define RLX_AGENT __ATOMIC_RELAXED, __HIP_MEMORY_SCOPE_AGENT
#define LDS_WAIT() asm volatile("s_waitcnt lgkmcnt(0)" ::: "memory")
#define VM_WAIT() asm volatile("s_waitcnt vmcnt(0)" ::: "memory")

__device__ __forceinline__ unsigned cvt_pk_bf16(float lo, float hi) { unsigned r; asm volatile("v_cvt_pk_bf16_f32 %0, %1, %2" : "=v"(r) : "v"(lo), "v"(hi)); return r; }
__device__ __forceinline__ float bf_lo(unsigned w) { return __uint_as_float(w << 16); }
__device__ __forceinline__ float bf_hi(unsigned w) { return __uint_as_float(w & 0xffff0000u); }
__device__ __forceinline__ float wave_sum(float v) {
#pragma unroll
    for (int o = 1; o < 64; o <<= 1) v += __shfl_xor(v, o);
    return v;
}
__device__ __forceinline__ float fast_sigm(float y) { return __builtin_amdgcn_rcpf(1.0f + __builtin_amdgcn_exp2f(-1.4426950408889634f * y)); }
__device__ __forceinline__ float fast_gelu(float x) { return x * fast_sigm(1.5957691216057308f * (x + 0.044715f * x * x * x)); }

#define XB_TMO      128
#define XB_XCNT(j)  (256  + 64 * (j))
#define XB_XSUB(j)  (1280 + 64 * (j))
#define XB_XGEN(j)  (2304 + 64 * (j))
#define XB_TOP      3328
#define XB_TOPGEN   3392
#define XCD_BAR_WORDS 3456
#define XB_SPIN_CAP (1u << 18)
__device__ __forceinline__ unsigned xb_ld(unsigned* p)              { return __hip_atomic_load(p, __ATOMIC_RELAXED, __HIP_MEMORY_SCOPE_AGENT); }
__device__ __forceinline__ unsigned xb_add(unsigned* p, unsigned v) { return __hip_atomic_fetch_add(p, v, __ATOMIC_RELAXED, __HIP_MEMORY_SCOPE_AGENT); }
__device__ __forceinline__ unsigned xb_xcc_id() { return (unsigned)__builtin_amdgcn_s_getreg((3 << 11) | 20) & 0xFu; }
#define XB_SPIN(cond, bar) do { unsigned _sp = 0; while (cond) { __builtin_amdgcn_s_sleep(1); \
    if ((++_sp & 255u) == 0u) { if (xb_ld(&(bar)[XB_TMO])) break; if (_sp > XB_SPIN_CAP) { atomicAdd(&(bar)[XB_TMO], 1u); break; } } } } while (0)
struct XcdBarrier { unsigned* bar; unsigned x; volatile LAS unsigned* st; };
__device__ __forceinline__ XcdBarrier xcd_barrier_post(unsigned* bar, volatile LAS unsigned* st) {
    XcdBarrier b; b.bar = bar; b.x = xb_xcc_id(); b.st = st;
    if (threadIdx.x == 0) (void)xb_add(&bar[XB_XCNT(b.x)], 1u);
    return b;
}
__device__ __forceinline__ void xcd_barrier_complete(unsigned* bar, unsigned x, unsigned& nloc, unsigned& nx) {
    const unsigned G = gridDim.x * gridDim.y * gridDim.z;
    unsigned sum, cnt, mine, sp = 0u;
    for (;;) {
        sum = 0u; cnt = 0u; mine = 0u;
#pragma unroll
        for (unsigned j = 0; j < 16; ++j) { const unsigned c = xb_ld(&bar[XB_XCNT(j)]); sum += c; cnt += (c > 0u) ? 1u : 0u; mine = (j == x) ? c : mine; }
        if (sum == G) break;
        __builtin_amdgcn_s_sleep(1);
        if ((++sp & 255u) == 0u) { if (xb_ld(&bar[XB_TMO])) break; if (sp > XB_SPIN_CAP) { atomicAdd(&bar[XB_TMO], 1u); break; } }
    }
    nloc = mine > 0u ? mine : 1u; nx = cnt > 0u ? cnt : 1u;
}
__device__ __forceinline__ void xcd_barrier(const XcdBarrier& b) {
    asm volatile("s_waitcnt vmcnt(0)" ::: "memory");
    __syncthreads();
    if (threadIdx.x == 0) {
        unsigned* bar = b.bar;
        __builtin_amdgcn_s_waitcnt(0);
        unsigned nloc = b.st[0], nx = b.st[1];
        if (nloc == 0u) { xcd_barrier_complete(bar, b.x, nloc, nx); b.st[0] = nloc; b.st[1] = nx; }
        const unsigned old = xb_add(&bar[XB_XSUB(b.x)], 1u);
        const unsigned gen = old / nloc;
        if (old + 1u == (gen + 1u) * nloc) {
            __builtin_amdgcn_fence(__ATOMIC_RELEASE, "agent");
            asm volatile("s_waitcnt vmcnt(0)" ::: "memory");
            const unsigned og = xb_add(&bar[XB_TOP], 1u);
            const unsigned tg = og / nx;
            if (og + 1u == (tg + 1u) * nx) xb_add(&bar[XB_TOPGEN], 1u);
            else XB_SPIN(xb_ld(&bar[XB_TOPGEN]) == tg, bar);
            __builtin_amdgcn_fence(__ATOMIC_ACQUIRE, "agent");
            xb_add(&bar[XB_XGEN(b.x)], 1u);
            asm volatile("s_waitcnt vmcnt(0)" ::: "memory");
        } else {
            XB_SPIN(xb_ld(&bar[XB_XGEN(b.x)]) == gen, bar);
            __builtin_amdgcn_fence(__ATOMIC_ACQUIRE, "agent");
            asm volatile("s_waitcnt vmcnt(0)" ::: "memory");
        }
    }
    __syncthreads();
}

namespace pg8 {
constexpr int BM = 256, BK = 64, HALF = 128, HTB = HALF * BK * 2, STAGE_BYTES = 8 * HTB, NXCD = 8, WGM = 8;
__host__ __device__ __forceinline__ int lds_byte(int r, int c) { const int st = (r >> 4) * 2 + (c >> 5), rr = r & 15, cc = c & 31, ob = rr * 64 + cc * 2; return st * 1024 + (ob ^ (((ob >> 9) & 1) << 5)); }
__host__ __device__ __forceinline__ void stage_rc(int b, int& R, int& C) { const int st = b / 1024, sb = b % 1024, swz = sb ^ (((sb >> 9) & 1) << 5); R = (st >> 1) * 16 + swz / 64; C = (st & 1) * 32 + (swz % 64) / 2; }
__host__ __device__ __forceinline__ int perm32(int rho) { const int n = rho >> 4, i = rho & 15; return 8 * (i >> 2) + 4 * n + (i & 3); }
__host__ __device__ __forceinline__ int xcd_remap(int L, int nwg) { const int q = nwg / NXCD, r = nwg % NXCD, xcd = L % NXCD, off = L / NXCD; return (xcd < r ? xcd * (q + 1) : r * (q + 1) + (xcd - r) * q) + off; }

struct Unit { const char* a; const char* b; int m0, n0, e, cnt, lb; };

struct StaticOrder {
    int nM, nN, nwg, G, c;
    __host__ __device__ void init(int M, int N, int G_, int c_) { nM = M / BM; nN = N / BM; nwg = nM * nN; G = G_; c = c_; }
    __host__ __device__ bool next(int i, int& pm, int& pn) const {
        const long L = (long)i * G + c; if (L >= nwg) return false;
        const int wgid = xcd_remap((int)L, nwg);
        const int nig = WGM * nN, gid = wgid / nig, fm = gid * WGM, gsz = (nM - fm) < WGM ? (nM - fm) : WGM;
        pm = fm + ((wgid % nig) % gsz); pn = (wgid % nig) / gsz; return true;
    }
};

template <class P>
__device__ __forceinline__ void gemm_phase(LAS unsigned char* lds, const P& S) {
    constexpr int K = P::K, nt = K / BK;
    const int tid = threadIdx.x, wid = __builtin_amdgcn_readfirstlane(tid >> 6), lane = tid & 63, wr = wid >> 2, wc = wid & 3, fr = lane & 15, fq = lane >> 4;
    int Rs[2], Cs[2]; unsigned voffB[2];
#pragma unroll
    for (int i = 0; i < 2; ++i) { int R, C; stage_rc(tid * 16 + i * 8192, R, C); Rs[i] = R; Cs[i] = C; const int Rb = P::PERM ? ((R & ~31) + perm32(R & 31)) : R; voffB[i] = (unsigned)(Rb * K + C) * 2u; }
    constexpr size_t kstep = (size_t)(BK * 2);
    constexpr size_t hstep = (size_t)HALF * K * 2;
    const unsigned ldsw = (unsigned)wid * 1024u;
    const int aoff = lds_byte(wr * 64 + fr, fq * 8), boff = lds_byte(wc * 32 + fr, fq * 8);
#define PG8_SA(b, h) (((b) * 2 + (h)) * HTB)
#define PG8_SB(b, h) ((4 + (b) * 2 + (h)) * HTB)
#define PG8_STAGE_B(bufoff, gbase) do { _Pragma("unroll") for (int _i = 0; _i < 2; ++_i) \
        __builtin_amdgcn_global_load_lds((const unsigned*)((const char*)(gbase) + voffB[_i]), (LAS unsigned*)(lds + (bufoff) + ldsw + _i * 8192), 16, 0, 0); } while (0)
#define PG8_STAGE_A(bufoff, gbase, offs, h) do { _Pragma("unroll") for (int _i = 0; _i < 2; ++_i) \
        __builtin_amdgcn_global_load_lds((const unsigned*)((const char*)(gbase) + (offs)[h][_i]), (LAS unsigned*)(lds + (bufoff) + ldsw + _i * 8192), 16, 0, 0); } while (0)
#define PG8_LDA(dst, b, h) do { _Pragma("unroll") for (int m = 0; m < 4; ++m) _Pragma("unroll") for (int k = 0; k < 2; ++k) dst[m][k] = *(const LAS bf16x8*)(lds + PG8_SA(b, h) + aoff + m * 2048 + k * 1024); } while (0)
#define PG8_LDB(dst, b, h) do { _Pragma("unroll") for (int n = 0; n < 2; ++n) _Pragma("unroll") for (int k = 0; k < 2; ++k) dst[n][k] = *(const LAS bf16x8*)(lds + PG8_SB(b, h) + boff + n * 2048 + k * 1024); } while (0)
#define PG8_MMA(ai, bj, At, Bt) do { __builtin_amdgcn_s_setprio(1); _Pragma("unroll") for (int m = 0; m < 4; ++m) _Pragma("unroll") for (int n = 0; n < 2; ++n) _Pragma("unroll") for (int k = 0; k < 2; ++k) \
        acc[ai][bj][m][n] = __builtin_amdgcn_mfma_f32_16x16x32_bf16(Bt[n][k], At[m][k], acc[ai][bj][m][n], 0, 0, 0); __builtin_amdgcn_s_setprio(0); } while (0)
#define PG8_WAIT_V(n) asm volatile("s_waitcnt vmcnt(" #n ")" ::: "memory")
#define PG8_WAIT_L(n) asm volatile("s_waitcnt lgkmcnt(" #n ")" ::: "memory")
#define PG8_BAR __builtin_amdgcn_s_barrier()
#define PG8_SCHED __builtin_amdgcn_sched_barrier(0)
    Unit cur, nxt; int ui = 0;
    if (!S.next(0, cur)) return;
    f32x4 acc[2][2][4][2];
#pragma unroll
    for (int a = 0; a < 2; ++a)
#pragma unroll
        for (int b = 0; b < 2; ++b)
#pragma unroll
            for (int m = 0; m < 4; ++m)
#pragma unroll
                for (int n = 0; n < 2; ++n) acc[a][b][m][n] = (f32x4){0.f, 0.f, 0.f, 0.f};
    bf16x8 At[4][2], B0[2][2], B1[2][2];
    unsigned vAc[2][2], vAn[2][2];
#pragma unroll
    for (int h = 0; h < 2; ++h)
#pragma unroll
        for (int i = 0; i < 2; ++i) {
            if constexpr (P::GATHER) vAc[h][i] = S.row_off(cur, h * HALF + Rs[i]) + (unsigned)Cs[i] * 2u;
            else vAc[h][i] = (unsigned)((h * HALF + Rs[i]) * K + Cs[i]) * 2u;
            vAn[h][i] = vAc[h][i];
        }
    const char* cA = cur.a; const char* cB = cur.b;
    PG8_STAGE_B(PG8_SB(0, 0), cB); PG8_STAGE_B(PG8_SB(0, 1), cB + hstep); PG8_STAGE_A(PG8_SA(0, 0), cA, vAc, 0); PG8_STAGE_A(PG8_SA(0, 1), cA, vAc, 1);
    if (wr == 1) PG8_BAR;
    PG8_WAIT_V(2); PG8_BAR;
    PG8_STAGE_B(PG8_SB(1, 0), cB + kstep); PG8_STAGE_A(PG8_SA(1, 0), cA + kstep, vAc, 0); PG8_STAGE_B(PG8_SB(1, 1), cB + hstep + kstep);
    PG8_WAIT_V(6); PG8_BAR;
    for (;;) {
        const bool has_next = S.next(ui + 1, nxt);
        const char* nA = has_next ? nxt.a : cA; const char* nB = has_next ? nxt.b : cB;
        if constexpr (P::GATHER) {
            if (has_next) {
#pragma unroll
                for (int h = 0; h < 2; ++h)
#pragma unroll
                    for (int i = 0; i < 2; ++i) vAn[h][i] = S.row_off(nxt, h * HALF + Rs[i]) + (unsigned)Cs[i] * 2u;
            }
        }
#pragma clang loop unroll(disable)
        for (int t = 0; t < nt; t += 2) {
            const bool last = (t == nt - 2);
            const char* a1 = cA + (size_t)(t + 1) * kstep;
            const char* a2 = last ? nA : cA + (size_t)(t + 2) * kstep; const char* b2 = last ? nB : cB + (size_t)(t + 2) * kstep;
            const char* a3 = a2 + kstep; const char* b3 = b2 + kstep;
            unsigned o2[2][2];
#pragma unroll
            for (int h = 0; h < 2; ++h)
#pragma unroll
                for (int i = 0; i < 2; ++i) o2[h][i] = (P::GATHER && last) ? vAn[h][i] : vAc[h][i];
            PG8_LDB(B0, 0, 0); PG8_LDB(B1, 0, 1); PG8_SCHED; PG8_LDA(At, 0, 0); PG8_STAGE_A(PG8_SA(1, 1), a1, vAc, 1);
            PG8_WAIT_V(8); PG8_WAIT_L(0); PG8_BAR; PG8_MMA(0, 0, At, B0); PG8_MMA(0, 1, At, B1); PG8_BAR; PG8_SCHED;
            PG8_LDA(At, 0, 1); PG8_STAGE_B(PG8_SB(0, 0), b2); PG8_STAGE_B(PG8_SB(0, 1), b2 + hstep); PG8_STAGE_A(PG8_SA(0, 0), a2, o2, 0);
            PG8_WAIT_V(8); PG8_WAIT_L(0); PG8_BAR; PG8_MMA(1, 0, At, B0); PG8_MMA(1, 1, At, B1); PG8_BAR; PG8_SCHED;
            PG8_LDB(B0, 1, 0); PG8_LDB(B1, 1, 1); PG8_SCHED; PG8_LDA(At, 1, 0); PG8_STAGE_A(PG8_SA(0, 1), a2, o2, 1);
            PG8_WAIT_V(8); PG8_WAIT_L(0); PG8_BAR; PG8_MMA(0, 0, At, B0); PG8_MMA(0, 1, At, B1); PG8_BAR; PG8_SCHED;
            PG8_LDA(At, 1, 1); PG8_STAGE_B(PG8_SB(1, 0), b3); PG8_STAGE_B(PG8_SB(1, 1), b3 + hstep); PG8_STAGE_A(PG8_SA(1, 0), a3, o2, 0);
            PG8_WAIT_V(8); PG8_WAIT_L(0); PG8_BAR; PG8_MMA(1, 0, At, B0); PG8_MMA(1, 1, At, B1); PG8_BAR; PG8_SCHED;
        }
        if (wr == 0) PG8_BAR;
        if constexpr (!P::AFTER_DRAIN) S.epi(acc, cur, wr, wc, fr, fq);
        if (!has_next) break;
#pragma unroll
        for (int a = 0; a < 2; ++a)
#pragma unroll
            for (int b = 0; b < 2; ++b)
#pragma unroll
                for (int m = 0; m < 4; ++m)
#pragma unroll
                    for (int n = 0; n < 2; ++n) acc[a][b][m][n] = (f32x4){0.f, 0.f, 0.f, 0.f};
        cur = nxt; cA = nA; cB = nB; ++ui;
#pragma unroll
        for (int h = 0; h < 2; ++h)
#pragma unroll
            for (int i = 0; i < 2; ++i) vAc[h][i] = vAn[h][i];
        if (wr == 1) PG8_BAR;
    }
    PG8_WAIT_V(0);
    PG8_BAR;
    if constexpr (P::AFTER_DRAIN) S.epi_drain(acc, cur, wr, wc, fr, fq, lds);
#undef PG8_SA
#undef PG8_SB
#undef PG8_STAGE_A
#undef PG8_STAGE_B
#undef PG8_LDA
#undef PG8_LDB
#undef PG8_MMA
#undef PG8_WAIT_V
#undef PG8_WAIT_L
#undef PG8_BAR
#undef PG8_SCHED
}
}
constexpr size_t MiB = (size_t)1 << 20;
constexpr size_t WS_CTL = 0, CTL_ZERO_BYTES = 1 * MiB;
constexpr size_t WS_BT1 = 2 * MiB;
constexpr size_t WS_BT2 = 16 * MiB;
constexpr size_t WS_WR = 18 * MiB;
constexpr size_t WS_WSB = 19 * MiB;
constexpr size_t WS_BTGU = 20 * MiB;
constexpr size_t WS_BTD = 148 * MiB;
constexpr size_t WS_H = 212 * MiB;
constexpr size_t WS_C = 244 * MiB;
constexpr size_t WS_P = WS_C, WS_Q = WS_C + 32 * MiB, WS_R = WS_C + 64 * MiB, WS_V = WS_C + 96 * MiB;
constexpr size_t WS_H2 = WS_C, WS_HID = WS_C + 32 * MiB, WS_Y = WS_C + 96 * MiB;
constexpr size_t WS_PLG = WS_Y;
constexpr int PLW = 84;
constexpr size_t WS_LTOK = 404 * MiB, WS_LW = 408 * MiB, WS_LRS = 412 * MiB;
constexpr size_t WS_X2 = 420 * MiB;
constexpr size_t WS_ROUTE = 416 * MiB;
constexpr size_t WS_DBG = 417 * MiB;
constexpr size_t WS_NEED = 512 * MiB;
constexpr int CW_TMO = 0, CW_GCNT = 1024, CW_STAT = 2048, CW_BAR = 4096;
static_assert((CW_BAR + XCD_BAR_WORDS) * 4 <= (int)CTL_ZERO_BYTES, "ctl");
constexpr int RING_BYTES = 131072;
constexpr int TAB_OFF = RING_BYTES;
constexpr int PS_OFF = TAB_OFF + 4096;
constexpr int CN_OFF = PS_OFF + 320;
constexpr int MISC_OFF = CN_OFF + 256;
constexpr int LDS_BYTES = 147456;
static_assert(MISC_OFF + 16 <= LDS_BYTES, "lds");
constexpr int MAXU = 4;

struct Frame {
    LAS unsigned char* lds; int tid, lane, wave, G, bid;
    unsigned* ctl;
    const float *x, *g_mix, *w_in, *w_s, *b_s, *g_sgu, *w_conv, *w_out, *g_ffn, *w_rg, *w_re, *wg, *wu, *wd, *g_final;
    float* out; float* x2; unsigned char* ws;
};

struct TJob { const float* src; bf16_t* dst; int ld, ldd; };
constexpr int NJ_IN = 16 * 56, NJ_OUT = 16 * 8, NJ_GU = 64 * 16 * 8, NJ_DN = 64 * 8 * 8, NJOBS = NJ_IN + NJ_OUT + NJ_GU + NJ_DN;
__device__ __forceinline__ TJob tjob(const Frame& F, int j) {
    TJob J;
    if (j < NJ_IN) { const int kt = j / 56, nt = j % 56, pn = nt >> 1, bj = nt & 1; int sc;
        if (pn < 8) sc = bj ? 5120 + 128 * pn : 128 * pn;
        else if (pn < 16) sc = bj ? 6144 + 128 * (pn - 8) : 2048 + 128 * (pn - 8);
        else if (pn < 24) sc = bj ? 4096 + 128 * (pn - 16) : 3072 + 128 * (pn - 16);
        else sc = 1024 + 256 * (pn - 24) + 128 * bj;
        J.src = F.w_in + (size_t)(kt * 64) * NP + sc; J.ld = NP; J.dst = (bf16_t*)(F.ws + WS_BT1) + (size_t)(nt * 128) * 1024 + kt * 64; J.ldd = 1024; return J; }
    j -= NJ_IN;
    if (j < NJ_OUT) { const int kt = j / 8, nt = j % 8;
        J.src = F.w_out + (size_t)(kt * 64) * D + nt * 128; J.ld = D; J.dst = (bf16_t*)(F.ws + WS_BT2) + (size_t)(nt * 128) * 1024 + kt * 64; J.ldd = 1024; return J; }
    j -= NJ_OUT;
    if (j < NJ_GU) { const int e = j / 128, r = j % 128, kt = r / 8, nt = r % 8, jj = nt >> 1, bj = nt & 1;
        J.src = (bj ? F.wu : F.wg) + (size_t)e * 1024 * 512 + (size_t)(kt * 64) * 512 + jj * 128; J.ld = 512;
        J.dst = (bf16_t*)(F.ws + WS_BTGU) + ((size_t)e * 1024 + jj * 256 + bj * 128) * 1024 + kt * 64; J.ldd = 1024; return J; }
    j -= NJ_GU;
    { const int e = j / 64, r = j % 64, kt = r / 8, nt = r % 8;
      J.src = F.wd + (size_t)e * 512 * 1024 + (size_t)(kt * 64) * 1024 + nt * 128; J.ld = 1024;
      J.dst = (bf16_t*)(F.ws + WS_BTD) + ((size_t)e * 1024 + nt * 128) * 512 + kt * 64; J.ldd = 512; return J; }
}
__device__ __forceinline__ unsigned off_b(unsigned row, unsigned ch) { return 256u * row + 16u * (ch ^ (((row & 3) << 2) | ((row >> 2) & 3))); }
__device__ __forceinline__ unsigned tr_read_addr_16(unsigned lane, unsigned c, unsigned ks, unsigned t) {
    const unsigned g = lane >> 4, q = (lane & 15) >> 2, p = lane & 3;
    return off_b(32 * ks + 8 * g + 4 * t + q, 2 * c + (p >> 1)) + 8 * (p & 1);
}
__device__ __forceinline__ void convert_jobs(const Frame& F, int jlo, int jhi) {
    LAS float* tile0 = (LAS float*)F.lds;
    const int kr = F.tid >> 5, n4 = (F.tid & 31) * 4;
    f32x4 v0[4], v1[4], v2[4];
#define CJ_LOAD(v, jj) do { if ((jj) < jhi) { const TJob J_ = tjob(F, (jj)); _Pragma("unroll") for (int p = 0; p < 4; ++p) v[p] = __builtin_nontemporal_load((const f32x4*)(J_.src + (size_t)(kr + 16 * p) * J_.ld + n4)); } } while (0)
#define CJ_STEP(v, jj, par) do { if ((jj) < jhi) { const TJob J_ = tjob(F, (jj)); LAS float* tile = tile0 + (par) * (64 * 129); \
        _Pragma("unroll") for (int p = 0; p < 4; ++p) { LAS float* d = tile + (kr + 16 * p) * 129 + n4; d[0] = v[p][0]; d[1] = v[p][1]; d[2] = v[p][2]; d[3] = v[p][3]; } \
        CJ_LOAD(v, (jj) + 3 * F.G); \
        __syncthreads(); \
        _Pragma("unroll") for (int rep = 0; rep < 2; ++rep) { const int n = (F.tid >> 3) + 64 * rep, k8 = (F.tid & 7) * 8; const LAS float* s_ = tile + k8 * 129 + n; \
            u32x4 o; o.x = cvt_pk_bf16(s_[0], s_[129]); o.y = cvt_pk_bf16(s_[2 * 129], s_[3 * 129]); o.z = cvt_pk_bf16(s_[4 * 129], s_[5 * 129]); o.w = cvt_pk_bf16(s_[6 * 129], s_[7 * 129]); \
            *(u32x4*)(J_.dst + (size_t)n * J_.ldd + k8) = o; } } } while (0)
    int j = jlo + F.bid;
    CJ_LOAD(v0, j); CJ_LOAD(v1, j + F.G); CJ_LOAD(v2, j + 2 * F.G);
    for (; j < jhi; j += 6 * F.G) {
        CJ_STEP(v0, j, 0); CJ_STEP(v1, j + F.G, 1); CJ_STEP(v2, j + 2 * F.G, 0);
        CJ_STEP(v0, j + 3 * F.G, 1); CJ_STEP(v1, j + 4 * F.G, 0); CJ_STEP(v2, j + 5 * F.G, 1);
    }
    __syncthreads();
#undef CJ_LOAD
#undef CJ_STEP
}
constexpr int NI_GU = 64 * 16 * 32, NI_DN = 64 * 8 * 32, NITEMS_X = NI_GU + NI_DN;
__device__ __forceinline__ void xitem(const Frame& F, int id, const float*& src, int& ld, bf16_t*& dst, int& ldd) {
    if (id < NI_GU) { const int e = id >> 9, r = id & 511, kt = r >> 5, nb = r & 31, jj = nb >> 3, bj = (nb >> 2) & 1, sub = nb & 3;
        src = (bj ? F.wu : F.wg) + (size_t)e * 1024 * 512 + (size_t)(kt * 64) * 512 + jj * 128 + sub * 32; ld = 512;
        dst = (bf16_t*)(F.ws + WS_BTGU) + ((size_t)e * 1024 + nb * 32) * 1024 + kt * 64; ldd = 1024; }
    else { id -= NI_GU; const int e = id >> 8, r = id & 255, kt = r >> 5, nb = r & 31;
        src = F.wd + (size_t)e * 512 * 1024 + (size_t)(kt * 64) * 1024 + nb * 32; ld = 1024;
        dst = (bf16_t*)(F.ws + WS_BTD) + ((size_t)e * 1024 + nb * 32) * 512 + kt * 64; ldd = 512; }
}
__device__ __forceinline__ void convert_experts_wave(const Frame& F) {
    LAS float* scr = (LAS float*)(F.lds + F.wave * 8448);
    const int gw = F.bid * NWAVES + F.wave, NGW = F.G * NWAVES;
    const int lk = F.lane >> 5, ln = F.lane & 31;
    const int c8 = F.lane & 7, nr = F.lane >> 3;
    float va[32], vb[32], vc[32];
#define XI_LOAD(v, id) do { if ((id) < NITEMS_X) { const float* s_; int ld_; bf16_t* d_; int ldd_; xitem(F, (id), s_, ld_, d_, ldd_); \
        _Pragma("unroll") for (int i = 0; i < 32; ++i) v[i] = __builtin_nontemporal_load(s_ + (size_t)(2 * i + lk) * ld_ + ln); } } while (0)
#define XI_STEP(v, id) do { if ((id) < NITEMS_X) { const float* s_; int ld_; bf16_t* d_; int ldd_; xitem(F, (id), s_, ld_, d_, ldd_); \
        _Pragma("unroll") for (int i = 0; i < 32; ++i) scr[(2 * i + lk) * 33 + ln] = v[i]; \
        XI_LOAD(v, (id) + 3 * NGW); \
        f32x4 g0_ = (f32x4){1.f, 1.f, 1.f, 1.f}, g1_ = g0_; if ((id) < NI_GU) { const float* gp_ = F.g_ffn + (((id) & 511) >> 5) * 64 + 8 * c8; g0_ = *(const f32x4*)gp_; g1_ = *(const f32x4*)(gp_ + 4); }     \
        _Pragma("unroll") for (int j = 0; j < 4; ++j) { const int n = nr + 8 * j; const LAS float* t_ = scr + (8 * c8) * 33 + n; \
            u32x4 o; o.x = cvt_pk_bf16(t_[0] * g0_[0], t_[33] * g0_[1]); o.y = cvt_pk_bf16(t_[2 * 33] * g0_[2], t_[3 * 33] * g0_[3]); o.z = cvt_pk_bf16(t_[4 * 33] * g1_[0], t_[5 * 33] * g1_[1]); o.w = cvt_pk_bf16(t_[6 * 33] * g1_[2], t_[7 * 33] * g1_[3]); \
            *(u32x4*)(d_ + (size_t)n * ldd_ + 8 * c8) = o; } } } while (0)
    int id = gw;
    XI_LOAD(va, id); XI_LOAD(vb, id + NGW); XI_LOAD(vc, id + 2 * NGW);
    for (; id < NITEMS_X; id += 3 * NGW) { XI_STEP(va, id); XI_STEP(vb, id + NGW); XI_STEP(vc, id + 2 * NGW); }
#undef XI_LOAD
#undef XI_STEP
    __syncthreads();
}
__device__ __forceinline__ void phase_prologue(const Frame& F) {
    convert_jobs(F, 0, NJ_IN + NJ_OUT);
    { bf16_t* hi = (bf16_t*)(F.ws + WS_WR); bf16_t* lo = hi + 80 * 1024;
      for (int i = F.bid * NTHR + F.tid; i < 80 * 1024; i += F.G * NTHR) { const int jj = i >> 10, c = i & 1023;
          float w = 0.f; if (jj < 64) w = F.w_re[c * 64 + jj] * F.g_ffn[c]; else if (jj < 72) w = F.w_rg[c * 8 + (jj - 64)] * F.g_ffn[c];
          const unsigned h = cvt_pk_bf16(w, 0.f) & 0xffffu; const float r = w - __uint_as_float(h << 16);
          hi[i] = (bf16_t)h; lo[i] = (bf16_t)(cvt_pk_bf16(r, 0.f) & 0xffffu); } }
    { bf16_t* o = (bf16_t*)(F.ws + WS_WSB);
      for (int i = F.bid * NTHR + F.tid; i < 8 * 128 * 128; i += F.G * NTHR) o[i] = (bf16_t)(cvt_pk_bf16(F.w_s[i], 0.f) & 0xffffu); }
    { bf16_t* H = (bf16_t*)(F.ws + WS_H);
      f32x4 g[4];
#pragma unroll
      for (int q = 0; q < 4; ++q) g[q] = *(const f32x4*)(F.g_mix + 4 * F.lane + 256 * q);
      for (int row = F.bid * NWAVES + F.wave; row < T; row += F.G * NWAVES) {
          const float* xr = F.x + (size_t)row * D + 4 * F.lane; f32x4 a[4]; float s = 0.f;
#pragma unroll
          for (int q = 0; q < 4; ++q) { a[q] = *(const f32x4*)(xr + 256 * q); s += (a[q][0] * a[q][0] + a[q][1] * a[q][1]) + (a[q][2] * a[q][2] + a[q][3] * a[q][3]); }
          const float r = 1.0f / sqrtf(wave_sum(s) * (1.0f / D) + EPS);
#pragma unroll
          for (int q = 0; q < 4; ++q) { u32x2 o; o.x = cvt_pk_bf16(a[q][0] * r * g[q][0], a[q][1] * r * g[q][1]); o.y = cvt_pk_bf16(a[q][2] * r * g[q][2], a[q][3] * r * g[q][3]);
              *(u32x2*)(H + (size_t)row * D + 4 * F.lane + 256 * q) = o; }
      } }
}

struct ProbProj {
    static constexpr int K = 1024; static constexpr bool PERM = true, GATHER = false, AFTER_DRAIN = false;
    const bf16_t* A; const bf16_t* Bt; pg8::StaticOrder so; bf16_t *Pp, *Qp, *Rp, *Vp; int ilo, ihi;
    __device__ __forceinline__ bool next(int i, pg8::Unit& u) const { int pm, pn; if (ilo + i >= ihi || !so.next(ilo + i, pm, pn)) return false; u.m0 = pm; u.n0 = pn; u.e = 0; u.cnt = 0; u.lb = 0;
        u.a = (const char*)A + (size_t)pm * 256 * K * 2; u.b = (const char*)Bt + (size_t)pn * 256 * K * 2; return true; }
    __device__ __forceinline__ unsigned row_off(const pg8::Unit&, int) const { return 0u; }
    __device__ __forceinline__ void epi(const f32x4 (&acc)[2][2][4][2], const pg8::Unit& u, int wr, int wc, int fr, int fq) const {
        const int pn = u.n0, row0 = u.m0 * 256 + wr * 64 + fr, cl = wc * 32 + 8 * fq;
        if (pn < 24) {
            const int ty = pn >> 3; bf16_t* dst = Pp + (size_t)ty * ((32 * MiB) / 2) + (pn & 7) * 128 + cl;
#pragma unroll
            for (int ai = 0; ai < 2; ++ai)
#pragma unroll
                for (int m = 0; m < 4; ++m) {
                    float o[8];
#pragma unroll
                    for (int n = 0; n < 2; ++n)
#pragma unroll
                        for (int q = 0; q < 4; ++q) { const float X = acc[ai][0][m][n][q], Y = acc[ai][1][m][n][q];
                            o[n * 4 + q] = (ty == 0) ? fast_gelu(X) * fast_sigm(Y) : ((ty == 1) ? X * fast_sigm(Y) : X * Y); }
                    u32x4 w; w.x = cvt_pk_bf16(o[0], o[1]); w.y = cvt_pk_bf16(o[2], o[3]); w.z = cvt_pk_bf16(o[4], o[5]); w.w = cvt_pk_bf16(o[6], o[7]);
                    *(u32x4*)(dst + (size_t)(row0 + ai * 128 + m * 16) * D) = w; }
        } else {
            bf16_t* dst = Vp + (pn - 24) * 256 + cl;
#pragma unroll
            for (int ai = 0; ai < 2; ++ai)
#pragma unroll
                for (int m = 0; m < 4; ++m)
#pragma unroll
                    for (int bj = 0; bj < 2; ++bj) {
                        float o[8];
#pragma unroll
                        for (int n = 0; n < 2; ++n)
#pragma unroll
                            for (int q = 0; q < 4; ++q) o[n * 4 + q] = fast_gelu(acc[ai][bj][m][n][q]);
                        u32x4 w; w.x = cvt_pk_bf16(o[0], o[1]); w.y = cvt_pk_bf16(o[2], o[3]); w.z = cvt_pk_bf16(o[4], o[5]); w.w = cvt_pk_bf16(o[6], o[7]);
                        *(u32x4*)(dst + (size_t)(row0 + ai * 128 + m * 16) * D + bj * 128) = w; }
        }
    }
};

__device__ __forceinline__ void phase_sgu(const Frame& F) {
    const bf16_t* Pp = (const bf16_t*)(F.ws + WS_P); const bf16_t* Qp = (const bf16_t*)(F.ws + WS_Q); const bf16_t* Rp = (const bf16_t*)(F.ws + WS_R); const bf16_t* Vp = (const bf16_t*)(F.ws + WS_V);
    const bf16_t* Wsb = (const bf16_t*)(F.ws + WS_WSB); bf16_t* Mg = (bf16_t*)(F.ws + WS_H);
    LAS unsigned char* VT = F.lds;
    LAS float* ZB = (LAS float*)(F.lds + 32768);
    const int ch = F.tid & 15, pr = F.tid >> 4;
    const unsigned vbase = (unsigned)(size_t)VT;
    for (int unit = F.bid; unit < 1024; unit += F.G) {
        const int chunk = unit >> 3, g = unit & 7, t0 = chunk * 128, c0 = g * 128;
        u32x4 pvv[4], qvv[4], r0v[4], rmv[4], rpv[4];
#pragma unroll
        for (int ps = 0; ps < 4; ++ps) { const int t = t0 + pr + 32 * ps; const size_t o = (size_t)t * D + c0 + 8 * ch; const int ts = t & (SEQ - 1);
            pvv[ps] = *(const u32x4*)(Pp + o); qvv[ps] = *(const u32x4*)(Qp + o); r0v[ps] = *(const u32x4*)(Rp + o);
            rmv[ps] = (u32x4){0u, 0u, 0u, 0u}; rpv[ps] = (u32x4){0u, 0u, 0u, 0u};
            if (ts > 0) rmv[ps] = *(const u32x4*)(Rp + o - D);
            if (ts < SEQ - 1) rpv[ps] = *(const u32x4*)(Rp + o + D); }
        float gs[8];
#pragma unroll
        for (int q = 0; q < 2; ++q) { const f32x4 t4 = *(const f32x4*)(F.g_sgu + c0 + 8 * ch + 4 * q); gs[4 * q] = t4[0]; gs[4 * q + 1] = t4[1]; gs[4 * q + 2] = t4[2]; gs[4 * q + 3] = t4[3]; }
#pragma unroll
        for (int ps = 0; ps < 4; ++ps) {
            const int p = pr + 32 * ps;
            const u32x4 raw = *(const u32x4*)(Vp + (size_t)(t0 + p) * D + c0 + 8 * ch);
            float v[8]; v[0] = bf_lo(raw.x); v[1] = bf_hi(raw.x); v[2] = bf_lo(raw.y); v[3] = bf_hi(raw.y); v[4] = bf_lo(raw.z); v[5] = bf_hi(raw.z); v[6] = bf_lo(raw.w); v[7] = bf_hi(raw.w);
            float s = ((v[0] + v[1]) + (v[2] + v[3])) + ((v[4] + v[5]) + (v[6] + v[7]));
            s += __shfl_xor(s, 1); s += __shfl_xor(s, 2); s += __shfl_xor(s, 4); s += __shfl_xor(s, 8);
            const float mean = s * (1.0f / 128.f); float qv = 0.f;
#pragma unroll
            for (int i = 0; i < 8; ++i) { v[i] -= mean; qv += v[i] * v[i]; }
            qv += __shfl_xor(qv, 1); qv += __shfl_xor(qv, 2); qv += __shfl_xor(qv, 4); qv += __shfl_xor(qv, 8);
            const float r = 1.0f / sqrtf(qv * (1.0f / 128.f) + EPS);
            u32x4 o; o.x = cvt_pk_bf16(v[0] * r * gs[0], v[1] * r * gs[1]); o.y = cvt_pk_bf16(v[2] * r * gs[2], v[3] * r * gs[3]);
            o.z = cvt_pk_bf16(v[4] * r * gs[4], v[5] * r * gs[5]); o.w = cvt_pk_bf16(v[6] * r * gs[6], v[7] * r * gs[7]);
            *(LAS u32x4*)(VT + off_b(p, ch)) = o;
        }
        __syncthreads();
        {
            const int q0 = 16 * F.wave; const int l15 = F.lane & 15, lq = F.lane >> 4;
            bf16x8 Yf[4];
#pragma unroll
            for (int ks = 0; ks < 4; ++ks) Yf[ks] = *(const bf16x8*)(Wsb + (size_t)(g * 128 + q0 + l15) * 128 + 32 * ks + 8 * lq);
            const float bq = F.b_s[g * 128 + q0 + l15];
#pragma unroll
            for (int ct = 0; ct < 8; ++ct) {
                const unsigned a0 = vbase + tr_read_addr_16(F.lane, ct, 0, 0), a1 = vbase + tr_read_addr_16(F.lane, ct, 0, 1);
                u16x4 x00, x01, x10, x11, x20, x21, x30, x31;
                asm volatile("ds_read_b64_tr_b16 %0, %8\n\tds_read_b64_tr_b16 %1, %9\n\tds_read_b64_tr_b16 %2, %8 offset:8192\n\tds_read_b64_tr_b16 %3, %9 offset:8192\n\t"
                             "ds_read_b64_tr_b16 %4, %8 offset:16384\n\tds_read_b64_tr_b16 %5, %9 offset:16384\n\tds_read_b64_tr_b16 %6, %8 offset:24576\n\tds_read_b64_tr_b16 %7, %9 offset:24576\n\t"
                             "s_waitcnt lgkmcnt(0)"
                             : "=&v"(x00), "=&v"(x01), "=&v"(x10), "=&v"(x11), "=&v"(x20), "=&v"(x21), "=&v"(x30), "=&v"(x31) : "v"(a0), "v"(a1) : "memory");
                f32x4 acc = (f32x4){0.f, 0.f, 0.f, 0.f};
                bf16x8 X;
                X = (bf16x8){(short)x00[0], (short)x00[1], (short)x00[2], (short)x00[3], (short)x01[0], (short)x01[1], (short)x01[2], (short)x01[3]}; acc = __builtin_amdgcn_mfma_f32_16x16x32_bf16(X, Yf[0], acc, 0, 0, 0);
                X = (bf16x8){(short)x10[0], (short)x10[1], (short)x10[2], (short)x10[3], (short)x11[0], (short)x11[1], (short)x11[2], (short)x11[3]}; acc = __builtin_amdgcn_mfma_f32_16x16x32_bf16(X, Yf[1], acc, 0, 0, 0);
                X = (bf16x8){(short)x20[0], (short)x20[1], (short)x20[2], (short)x20[3], (short)x21[0], (short)x21[1], (short)x21[2], (short)x21[3]}; acc = __builtin_amdgcn_mfma_f32_16x16x32_bf16(X, Yf[2], acc, 0, 0, 0);
                X = (bf16x8){(short)x30[0], (short)x30[1], (short)x30[2], (short)x30[3], (short)x31[0], (short)x31[1], (short)x31[2], (short)x31[3]}; acc = __builtin_amdgcn_mfma_f32_16x16x32_bf16(X, Yf[3], acc, 0, 0, 0);
                acc = acc + bq;
                *(LAS f32x4*)(ZB + (q0 + l15) * 132 + 16 * ct + 4 * lq) = acc;
            }
        }
        __syncthreads();
        {
            float w0[8], w1[8], w2[8];
#pragma unroll
            for (int q = 0; q < 2; ++q) { const f32x4 a = *(const f32x4*)(F.w_conv + c0 + 8 * ch + 4 * q), b = *(const f32x4*)(F.w_conv + 1024 + c0 + 8 * ch + 4 * q), c = *(const f32x4*)(F.w_conv + 2048 + c0 + 8 * ch + 4 * q);
#pragma unroll
                for (int i = 0; i < 4; ++i) { w0[4 * q + i] = a[i]; w1[4 * q + i] = b[i]; w2[4 * q + i] = c[i]; } }
#pragma unroll
            for (int ps = 0; ps < 4; ++ps) {
                const int q = pr + 32 * ps, t = t0 + q; const size_t o = (size_t)t * D + c0 + 8 * ch;
                const u32x4 pv = pvv[ps], qv = qvv[ps], r0 = r0v[ps], rm = rmv[ps], rp = rpv[ps];
                const f32x4 z0 = *(const LAS f32x4*)(ZB + q * 132 + 8 * ch), z1 = *(const LAS f32x4*)(ZB + q * 132 + 8 * ch + 4);
                float zz[8] = {z0[0], z0[1], z0[2], z0[3], z1[0], z1[1], z1[2], z1[3]};
                float res[8];
#pragma unroll
                for (int i = 0; i < 4; ++i) {
                    const unsigned pw = pv[i], qw = qv[i], rmw = rm[i], r0w = r0[i], rpw = rp[i];
                    res[2 * i] = bf_lo(pw) * zz[2 * i] + bf_lo(qw) * (w0[2 * i] * bf_lo(rmw) + w1[2 * i] * bf_lo(r0w) + w2[2 * i] * bf_lo(rpw));
                    res[2 * i + 1] = bf_hi(pw) * zz[2 * i + 1] + bf_hi(qw) * (w0[2 * i + 1] * bf_hi(rmw) + w1[2 * i + 1] * bf_hi(r0w) + w2[2 * i + 1] * bf_hi(rpw));
                }
                u32x4 w; w.x = cvt_pk_bf16(res[0], res[1]); w.y = cvt_pk_bf16(res[2], res[3]); w.z = cvt_pk_bf16(res[4], res[5]); w.w = cvt_pk_bf16(res[6], res[7]);
                *(u32x4*)(Mg + o) = w;
            }
        }
        __syncthreads();
    }
}

struct ProbOut {
    static constexpr int K = 1024; static constexpr bool PERM = true, GATHER = false, AFTER_DRAIN = true;
    const bf16_t* A; const bf16_t* Bt; pg8::StaticOrder so; const float* x; bf16_t* H2; const bf16_t* WRh; float* PLG;
    __device__ __forceinline__ bool next(int i, pg8::Unit& u) const { int pm, pn; if (i > 0 || !so.next(i, pm, pn)) return false; u.m0 = pm; u.n0 = pn; u.e = 0; u.cnt = 0; u.lb = 0;
        u.a = (const char*)A + (size_t)pm * 256 * K * 2; u.b = (const char*)Bt + (size_t)pn * 256 * K * 2; return true; }
    __device__ __forceinline__ unsigned row_off(const pg8::Unit&, int) const { return 0u; }
    __device__ __forceinline__ void epi(const f32x4 (&)[2][2][4][2], const pg8::Unit&, int, int, int, int) const {}
    __device__ __forceinline__ void epi_drain(f32x4 (&acc)[2][2][4][2], const pg8::Unit& u, int wr, int wc, int fr, int fq, LAS unsigned char* lds) const {
        const int tid = threadIdx.x;
        const int row0 = u.m0 * 256 + wr * 64 + fr, col0 = u.n0 * 256 + wc * 32 + 8 * fq;
        LAS float* PB = (LAS float*)lds;
        LAS float* SSP = (LAS float*)(lds + TAB_OFF);
#pragma unroll
        for (int ai = 0; ai < 2; ++ai)
#pragma unroll
            for (int m = 0; m < 4; ++m) {
                float ss = 0.f;
#pragma unroll
                for (int bj = 0; bj < 2; ++bj) {
                    const size_t o = (size_t)(row0 + ai * 128 + m * 16) * D + col0 + bj * 128;
                    const f32x4 v0 = acc[ai][bj][m][0] + *(const f32x4*)(x + o), v1 = acc[ai][bj][m][1] + *(const f32x4*)(x + o + 4);
                    ss += (v0[0] * v0[0] + v0[1] * v0[1]) + (v0[2] * v0[2] + v0[3] * v0[3]) + (v1[0] * v1[0] + v1[1] * v1[1]) + (v1[2] * v1[2] + v1[3] * v1[3]);
                    u32x4 h; h.x = cvt_pk_bf16(v0[0], v0[1]); h.y = cvt_pk_bf16(v0[2], v0[3]); h.z = cvt_pk_bf16(v1[0], v1[1]); h.w = cvt_pk_bf16(v1[2], v1[3]);
                    *(u32x4*)(H2 + o) = h;
                    u32x4 l; l.x = cvt_pk_bf16(v0[0] - bf_lo(h.x), v0[1] - bf_hi(h.x)); l.y = cvt_pk_bf16(v0[2] - bf_lo(h.y), v0[3] - bf_hi(h.y));
                    l.z = cvt_pk_bf16(v1[0] - bf_lo(h.z), v1[1] - bf_hi(h.z)); l.w = cvt_pk_bf16(v1[2] - bf_lo(h.w), v1[3] - bf_hi(h.w));
                    acc[ai][bj][m][0] = __builtin_bit_cast(f32x4, h); acc[ai][bj][m][1] = __builtin_bit_cast(f32x4, l);
                }
                ss += __shfl_xor(ss, 16); ss += __shfl_xor(ss, 32);
                if (fq == 0) SSP[wc * 256 + ai * 128 + wr * 64 + m * 16 + fr] = ss;
            }
        const int rrow = tid >> 1, rhalf = tid & 1;
        float* prow = PLG + ((size_t)(u.m0 * 256 + rrow) * 4 + u.n0) * PLW;
#pragma unroll 1
        for (int jt = 0; jt < 5; ++jt) {
            bf16x8 Wf[2][2];
#pragma unroll
            for (int bj = 0; bj < 2; ++bj) { const bf16_t* wp = WRh + (size_t)(16 * jt + fr) * 1024 + u.n0 * 256 + bj * 128 + wc * 32 + 8 * fq;
                Wf[bj][0] = *(const bf16x8*)wp; Wf[bj][1] = *(const bf16x8*)(wp + 80 * 1024); }
            LAS float* pb = PB + (jt & 1) * (4 * 256 * 16) + wc * (256 * 16);
#pragma unroll
            for (int ai = 0; ai < 2; ++ai)
#pragma unroll
                for (int m = 0; m < 4; ++m) {
                    f32x4 d = (f32x4){0.f, 0.f, 0.f, 0.f};
#pragma unroll
                    for (int bj = 0; bj < 2; ++bj) { const bf16x8 xh = __builtin_bit_cast(bf16x8, acc[ai][bj][m][0]), xl = __builtin_bit_cast(bf16x8, acc[ai][bj][m][1]);
                        d = __builtin_amdgcn_mfma_f32_16x16x32_bf16(Wf[bj][0], xh, d, 0, 0, 0);
                        d = __builtin_amdgcn_mfma_f32_16x16x32_bf16(Wf[bj][0], xl, d, 0, 0, 0);
                        d = __builtin_amdgcn_mfma_f32_16x16x32_bf16(Wf[bj][1], xh, d, 0, 0, 0); }
                    *(LAS f32x4*)(pb + (ai * 128 + wr * 64 + m * 16 + fr) * 16 + 4 * fq) = d;
                }
            __syncthreads();
            { const LAS float* q = PB + (jt & 1) * (4 * 256 * 16) + rrow * 16 + 8 * rhalf;
              f32x4 s0 = *(const LAS f32x4*)q, s1 = *(const LAS f32x4*)(q + 4);
#pragma unroll
              for (int w = 1; w < 4; ++w) { s0 = s0 + *(const LAS f32x4*)(q + w * 256 * 16); s1 = s1 + *(const LAS f32x4*)(q + w * 256 * 16 + 4); }
              *(f32x4*)(prow + 16 * jt + 8 * rhalf) = s0; *(f32x4*)(prow + 16 * jt + 8 * rhalf + 4) = s1;
              if (jt == 0 && rhalf == 0) prow[80] = (SSP[rrow] + SSP[256 + rrow]) + (SSP[512 + rrow] + SSP[768 + rrow]); }
        }
    }
};

__device__ __forceinline__ void phase_router(const Frame& F) {
    const float* PLG = (const float*)(F.ws + WS_PLG);
    int* ltok = (int*)(F.ws + WS_LTOK); float* lw = (float*)(F.ws + WS_LW); float* lrs = (float*)(F.ws + WS_LRS); float* route = (float*)(F.ws + WS_ROUTE);
    unsigned* gcnt = F.ctl + CW_GCNT;
    LAS float* LG = (LAS float*)F.lds;
    LAS int* hist = (LAS int*)(F.lds + 64 * PLW * 4);
    LAS int* base = hist + 64;
    for (int unit = F.bid; unit < T / 64; unit += F.G) {
        for (int e = F.tid; e < 64 * PLW; e += NTHR) { const int tt = e / PLW, c = e - tt * PLW; const float* p = PLG + ((size_t)(unit * 64 + tt) * 4) * PLW + c;
            LG[e] = (p[0] + p[PLW]) + (p[2 * PLW] + p[3 * PLW]); }
        if (F.tid < 64) hist[F.tid] = 0;
        __syncthreads();
        int e0 = 0, e1 = 0, lp0 = 0, lp1 = 0; float w0 = 0.f, w1 = 0.f, rstd = 0.f;
        if (F.tid < 64) {
            const LAS float* l0 = LG + F.tid * PLW;
            rstd = 1.0f / sqrtf(l0[80] * (1.0f / D) + EPS);
            int gi = 0; float gm = l0[64] * rstd;
#pragma unroll
            for (int j = 1; j < 8; ++j) { const float v = l0[64 + j] * rstd; if (v > gm) { gm = v; gi = j; } }
            float den = 0.f;
#pragma unroll
            for (int j = 0; j < 8; ++j) den += __expf(l0[64 + j] * rstd - gm);
            const float pg = 1.0f / den;
            const LAS float* ep = l0 + gi * 8;
            int i1 = 0; float m1 = ep[0] * rstd;
#pragma unroll
            for (int j = 1; j < 8; ++j) { const float v = ep[j] * rstd; if (v > m1) { m1 = v; i1 = j; } }
            int i2 = -1; float m2 = 0.f;
#pragma unroll
            for (int j = 0; j < 8; ++j) { const float v = ep[j] * rstd; if (j != i1 && (i2 < 0 || v > m2)) { m2 = v; i2 = j; } }
            const float ex = __expf(m2 - m1);
            e0 = gi * 8 + i1; e1 = gi * 8 + i2; w0 = pg / (1.0f + ex); w1 = pg * ex / (1.0f + ex);
            lp0 = __hip_atomic_fetch_add(hist + e0, 1, __ATOMIC_RELAXED, __HIP_MEMORY_SCOPE_WORKGROUP);
            lp1 = __hip_atomic_fetch_add(hist + e1, 1, __ATOMIC_RELAXED, __HIP_MEMORY_SCOPE_WORKGROUP);
        }
        __syncthreads();
        if (F.tid < 64) { const int hc = hist[F.tid]; base[F.tid] = hc ? (int)__hip_atomic_fetch_add(gcnt + F.tid, (unsigned)hc, RLX_AGENT) : 0; }
        __syncthreads();
        if (F.tid < 64) {
            const int t = unit * 64 + F.tid;
            const int p0 = base[e0] + lp0, p1 = base[e1] + lp1;
            ltok[e0 * LCAP + p0] = 2 * t; lw[e0 * LCAP + p0] = w0; lrs[e0 * LCAP + p0] = rstd;
            ltok[e1 * LCAP + p1] = 2 * t + 1; lw[e1 * LCAP + p1] = w1; lrs[e1 * LCAP + p1] = rstd;
            *(f32x4*)(route + (size_t)t * 4) = (f32x4){(float)e0, (float)e1, w0, w1};
        }
        __syncthreads();
    }
}

__device__ __forceinline__ void moe_tables(const Frame& F) {
    LAS int* ps = (LAS int*)(F.lds + PS_OFF); LAS int* cn = (LAS int*)(F.lds + CN_OFF);
    if (F.tid < 64) {
        const int c = (int)__hip_atomic_load(F.ctl + CW_GCNT + F.tid, RLX_AGENT); cn[F.tid] = c;
        int nb = (c + 255) >> 8, incl = nb;
#pragma unroll
        for (int o = 1; o < 64; o <<= 1) { const int v = __shfl_up(incl, o); if (F.lane >= o) incl += v; }
        ps[F.tid] = incl - nb; if (F.tid == 63) ps[64] = incl;
    }
    __syncthreads();
}
struct MoeOrder {
    LAS const int* ps; LAS const int* cn; int nunits, G, c;
    __device__ __forceinline__ bool locate(int i, int& blk, int& j, int& e, int& bin) const {
        const int L = i * G + c; if (L >= nunits) return false;
        const int id = pg8::xcd_remap(L, nunits); blk = id >> 2; j = id & 3;
        const int lane = threadIdx.x & 63;
        const unsigned long long m = __ballot(ps[lane] <= blk);
        e = __builtin_amdgcn_readfirstlane(__builtin_popcountll(m) - 1); bin = blk - ps[e]; return true;
    }
};
struct ProbGU {
    static constexpr int K = 1024; static constexpr bool PERM = true, GATHER = true, AFTER_DRAIN = false;
    const bf16_t* H2; const bf16_t* Bt; bf16_t* HID; const float* lrs; LAS const int* tab; MoeOrder mo;
    __device__ __forceinline__ bool next(int i, pg8::Unit& u) const { int blk, j, e, bin; if (!mo.locate(i, blk, j, e, bin)) return false;
        u.m0 = blk; u.n0 = j; u.e = i; u.cnt = mo.cn[e] - bin * 256; u.lb = e * LCAP + bin * 256;
        u.a = (const char*)H2; u.b = (const char*)Bt + ((size_t)e * 1024 + j * 256) * K * 2; return true; }
    __device__ __forceinline__ unsigned row_off(const pg8::Unit& u, int r) const { return (unsigned)tab[u.e * 256 + r] * (unsigned)(K * 2); }
    __device__ __forceinline__ void epi(const f32x4 (&acc)[2][2][4][2], const pg8::Unit& u, int wr, int wc, int fr, int fq) const {
        const int hc = u.n0 * 128 + wc * 32 + 8 * fq;
#pragma unroll
        for (int ai = 0; ai < 2; ++ai)
#pragma unroll
            for (int m = 0; m < 4; ++m) {
                const int rl = ai * 128 + wr * 64 + m * 16 + fr; const int idx = rl < u.cnt ? rl : u.cnt - 1;
                const float rs = lrs[u.lb + idx];
                float o[8];
#pragma unroll
                for (int n = 0; n < 2; ++n)
#pragma unroll
                    for (int q = 0; q < 4; ++q) { const float gt = acc[ai][0][m][n][q] * rs, up = acc[ai][1][m][n][q] * rs; o[n * 4 + q] = gt * fast_sigm(gt) * up; }
                u32x4 w; w.x = cvt_pk_bf16(o[0], o[1]); w.y = cvt_pk_bf16(o[2], o[3]); w.z = cvt_pk_bf16(o[4], o[5]); w.w = cvt_pk_bf16(o[6], o[7]);
                *(u32x4*)(HID + (size_t)(u.m0 * 256 + rl) * DE + hc) = w;
            }
    }
};
struct ProbDown {
    static constexpr int K = 512; static constexpr bool PERM = true, GATHER = false, AFTER_DRAIN = false;
    const bf16_t* HID; const bf16_t* Bt; bf16_t* Y; const int* ltok; const float* lw; MoeOrder mo;
    __device__ __forceinline__ bool next(int i, pg8::Unit& u) const { int blk, j, e, bin; if (!mo.locate(i, blk, j, e, bin)) return false;
        u.m0 = blk; u.n0 = j; u.e = e; u.cnt = mo.cn[e] - bin * 256; u.lb = e * LCAP + bin * 256;
        u.a = (const char*)HID + (size_t)blk * 256 * K * 2; u.b = (const char*)Bt + ((size_t)e * 1024 + j * 256) * K * 2; return true; }
    __device__ __forceinline__ unsigned row_off(const pg8::Unit&, int) const { return 0u; }
    __device__ __forceinline__ void epi(const f32x4 (&acc)[2][2][4][2], const pg8::Unit& u, int wr, int wc, int fr, int fq) const {
        const int col0 = u.n0 * 256 + wc * 32 + 8 * fq;
#pragma unroll
        for (int ai = 0; ai < 2; ++ai)
#pragma unroll
            for (int m = 0; m < 4; ++m) {
                const int rl = ai * 128 + wr * 64 + m * 16 + fr; const bool ok = rl < u.cnt; const int idx = ok ? rl : 0;
                const int tk = ltok[u.lb + idx]; const float w = lw[u.lb + idx];
                if (ok) {
#pragma unroll
                    for (int bj = 0; bj < 2; ++bj) {
                        const f32x4 a = acc[ai][bj][m][0] * w, b = acc[ai][bj][m][1] * w;
                        u32x4 o; o.x = cvt_pk_bf16(a[0], a[1]); o.y = cvt_pk_bf16(a[2], a[3]); o.z = cvt_pk_bf16(b[0], b[1]); o.w = cvt_pk_bf16(b[2], b[3]);
                        *(u32x4*)(Y + (size_t)tk * D + col0 + bj * 128) = o; }
                }
            }
    }
};
__device__ __forceinline__ void phase_moe_gu(const Frame& F) {
    moe_tables(F);
    LAS const int* ps = (LAS const int*)(F.lds + PS_OFF); LAS const int* cn = (LAS const int*)(F.lds + CN_OFF); LAS int* tab = (LAS int*)(F.lds + TAB_OFF);
    const int* ltok = (const int*)(F.ws + WS_LTOK);
    ProbGU P; P.H2 = (const bf16_t*)(F.ws + WS_H2); P.Bt = (const bf16_t*)(F.ws + WS_BTGU); P.HID = (bf16_t*)(F.ws + WS_HID); P.lrs = (const float*)(F.ws + WS_LRS); P.tab = tab;
    P.mo.ps = ps; P.mo.cn = cn; P.mo.nunits = ps[64] * 4; P.mo.G = F.G; P.mo.c = F.bid;
    for (int i = 0; i < MAXU; ++i) { int blk, j, e, bin; if (!P.mo.locate(i, blk, j, e, bin)) break;
        const int cnt = cn[e] - bin * 256;
        if (F.tid < 256) { const int idx = F.tid < cnt ? F.tid : cnt - 1; tab[i * 256 + F.tid] = ltok[e * LCAP + bin * 256 + idx] >> 1; } }
    __syncthreads();
    pg8::gemm_phase<ProbGU>(F.lds, P);
}
__device__ __forceinline__ void phase_moe_down(const Frame& F) {
    moe_tables(F);
    LAS const int* ps = (LAS const int*)(F.lds + PS_OFF); LAS const int* cn = (LAS const int*)(F.lds + CN_OFF);
    ProbDown P; P.HID = (const bf16_t*)(F.ws + WS_HID); P.Bt = (const bf16_t*)(F.ws + WS_BTD); P.Y = (bf16_t*)(F.ws + WS_Y); P.ltok = (const int*)(F.ws + WS_LTOK); P.lw = (const float*)(F.ws + WS_LW);
    P.mo.ps = ps; P.mo.cn = cn; P.mo.nunits = ps[64] * 4; P.mo.G = F.G; P.mo.c = F.bid;
    pg8::gemm_phase<ProbDown>(F.lds, P);
}

__device__ __forceinline__ void phase_final(const Frame& F) {
    const bf16_t* Y = (const bf16_t*)(F.ws + WS_Y);
    f32x4 g[4];
#pragma unroll
    for (int q = 0; q < 4; ++q) g[q] = *(const f32x4*)(F.g_final + 4 * F.lane + 256 * q);
    for (int row = F.bid * NWAVES + F.wave; row < T; row += F.G * NWAVES) {
        const bf16_t* xr = (const bf16_t*)(F.ws + WS_H2) + (size_t)row * D + 4 * F.lane; float* orow = F.out + (size_t)row * D + 4 * F.lane; const bf16_t* y0 = Y + (size_t)(2 * row) * D + 4 * F.lane; const bf16_t* y1 = y0 + D;
        f32x4 a[4]; float s = 0.f;
#pragma unroll
        for (int q = 0; q < 4; ++q) { const u32x2 ux = *(const u32x2*)(xr + 256 * q); a[q] = (f32x4){bf_lo(ux.x), bf_hi(ux.x), bf_lo(ux.y), bf_hi(ux.y)}; const u32x2 u0 = *(const u32x2*)(y0 + 256 * q), u1 = *(const u32x2*)(y1 + 256 * q);
            a[q][0] += bf_lo(u0.x) + bf_lo(u1.x); a[q][1] += bf_hi(u0.x) + bf_hi(u1.x); a[q][2] += bf_lo(u0.y) + bf_lo(u1.y); a[q][3] += bf_hi(u0.y) + bf_hi(u1.y);
            s += (a[q][0] * a[q][0] + a[q][1] * a[q][1]) + (a[q][2] * a[q][2] + a[q][3] * a[q][3]); }
        const float r = 1.0f / sqrtf(wave_sum(s) * (1.0f / D) + EPS);
#pragma unroll
        for (int q = 0; q < 4; ++q) *(f32x4*)(orow + 256 * q) = a[q] * r * g[q];
    }
}
constexpr int NPHASES = 8;
struct Args { const float* in[15]; float* out; unsigned char* ws; int ph_lo, ph_hi; };
__global__ void __launch_bounds__(NTHR, 2) fwd_kernel(Args args) {
    extern __shared__ __attribute__((aligned(16))) unsigned char lds_raw[];
    Frame F;
    F.lds = (LAS unsigned char*)lds_raw; F.tid = threadIdx.x; F.lane = F.tid & 63; F.wave = __builtin_amdgcn_readfirstlane(F.tid >> 6); F.G = gridDim.x; F.bid = blockIdx.x;
    F.ws = args.ws; F.ctl = (unsigned*)(args.ws + WS_CTL); F.out = args.out;
#ifndef X2_IN_WS
#define X2_IN_WS 0
#endif
    F.x2 = X2_IN_WS ? (float*)(args.ws + WS_X2) : args.out;
    F.x = args.in[0]; F.g_mix = args.in[1]; F.w_in = args.in[2]; F.w_s = args.in[3]; F.b_s = args.in[4]; F.g_sgu = args.in[5]; F.w_conv = args.in[6]; F.w_out = args.in[7];
    F.g_ffn = args.in[8]; F.w_rg = args.in[9]; F.w_re = args.in[10]; F.wg = args.in[11]; F.wu = args.in[12]; F.wd = args.in[13]; F.g_final = args.in[14];
    if (F.tid < 4) ((LAS unsigned*)(F.lds + MISC_OFF))[F.tid] = 0u;
    __syncthreads();
    const int lo = args.ph_lo, hi = args.ph_hi;
    const bool multi = (hi - lo) > 1;
    XcdBarrier bar; bar.bar = F.ctl + CW_BAR; bar.x = 0; bar.st = nullptr;
    if (multi) bar = xcd_barrier_post(F.ctl + CW_BAR, (volatile LAS unsigned*)(F.lds + MISC_OFF));
#define IN(k) (lo <= (k) && (k) < hi)
#ifndef PROBE_DOUBLE_BAR
#define PROBE_DOUBLE_BAR 0
#endif
#define SEAM(k) do { if (IN(k) && IN((k) + 1)) { xcd_barrier(bar); if (PROBE_DOUBLE_BAR) xcd_barrier(bar); } } while (0)
    if (IN(0)) { phase_prologue(F); } SEAM(0);
    if (IN(1)) {
        ProbProj P; P.A = (const bf16_t*)(F.ws + WS_H); P.Bt = (const bf16_t*)(F.ws + WS_BT1); P.so.init(T, NP, F.G, F.bid);
        P.Pp = (bf16_t*)(F.ws + WS_P); P.Qp = (bf16_t*)(F.ws + WS_Q); P.Rp = (bf16_t*)(F.ws + WS_R); P.Vp = (bf16_t*)(F.ws + WS_V);
        const int nper = (P.so.nwg + F.G - 1) / F.G; int split = 2 * (((F.bid >> 3) & 7) >> 1); if (split > nper) split = nper;
        if (split > 0) { P.ilo = 0; P.ihi = split; pg8::gemm_phase<ProbProj>(F.lds, P); }
        convert_experts_wave(F);
        if (split < nper) { P.ilo = split; P.ihi = nper; pg8::gemm_phase<ProbProj>(F.lds, P); }
    } SEAM(1);
    if (IN(2)) { phase_sgu(F); } SEAM(2);
    if (IN(3)) { ProbOut P; P.A = (const bf16_t*)(F.ws + WS_H); P.Bt = (const bf16_t*)(F.ws + WS_BT2); P.so.init(T, D, F.G, F.bid); P.x = F.x; P.H2 = (bf16_t*)(F.ws + WS_H2);
        P.WRh = (const bf16_t*)(F.ws + WS_WR); P.PLG = (float*)(F.ws + WS_PLG);
        pg8::gemm_phase<ProbOut>(F.lds, P); } SEAM(3);
    if (IN(4)) { phase_router(F); } SEAM(4);
    if (IN(5)) { phase_moe_gu(F); } SEAM(5);
    if (IN(6)) { phase_moe_down(F); } SEAM(6);
    if (IN(7)) { phase_final(F); }
#undef IN
#undef SEAM
}

#if DEBUG_CHECK
#ifndef REF_B
#define REF_B 0
#endif
__global__ void cmp_rows(const void* a, int a_bf16, const float* ref, int rows, float* stat) {
    float d2 = 0.f, r2 = 0.f;
    for (size_t i = (size_t)blockIdx.x * blockDim.x + threadIdx.x; i < (size_t)rows * 1024; i += (size_t)gridDim.x * blockDim.x) {
        const float av = a_bf16 ? __uint_as_float(((unsigned)((const bf16_t*)a)[i]) << 16) : ((const float*)a)[i]; const float rv = ref[i];
        const float d = av - rv; d2 += (d == d) ? d * d : 1e30f; r2 += rv * rv; }
    d2 = wave_sum(d2); r2 = wave_sum(r2);
    if ((threadIdx.x & 63) == 0) { atomicAdd(stat, d2); atomicAdd(stat + 1, r2); }
}
__global__ void cmp_pqrv(const bf16_t* Pp, const bf16_t* Qp, const bf16_t* Rp, const bf16_t* Vp, const float* proj, float* stat) {
    float d2[4] = {0.f, 0.f, 0.f, 0.f}, r2[4] = {0.f, 0.f, 0.f, 0.f};
    for (size_t i = (size_t)blockIdx.x * blockDim.x + threadIdx.x; i < (size_t)2048 * 1024; i += (size_t)gridDim.x * blockDim.x) {
        const size_t t = i >> 10; const int c = (int)(i & 1023); const float* pr = proj + t * 7168;
        const float rf[4] = {nv::gelu_t(pr[c]) * nv::sigm(pr[5120 + c]), pr[2048 + c] * nv::sigm(pr[6144 + c]), pr[3072 + c] * pr[4096 + c], nv::gelu_t(pr[1024 + c])};
        const float av[4] = {__uint_as_float(((unsigned)Pp[i]) << 16), __uint_as_float(((unsigned)Qp[i]) << 16), __uint_as_float(((unsigned)Rp[i]) << 16), __uint_as_float(((unsigned)Vp[i]) << 16)};
#pragma unroll
        for (int k = 0; k < 4; ++k) { const float d = av[k] - rf[k]; d2[k] += (d == d) ? d * d : 1e30f; r2[k] += rf[k] * rf[k]; } }
#pragma unroll
    for (int k = 0; k < 4; ++k) { const float a = wave_sum(d2[k]), b = wave_sum(r2[k]); if ((threadIdx.x & 63) == 0) { atomicAdd(stat + 2 * k, a); atomicAdd(stat + 2 * k + 1, b); } }
}
__global__ void cmp_route(const float* mine, const float* ref, float* stat) {
    const int t = blockIdx.x * blockDim.x + threadIdx.x; if (t >= 2048) return;
    const float a0 = mine[t * 4], a1 = mine[t * 4 + 1], b0 = ref[t * 4], b1 = ref[t * 4 + 1];
    const bool same = (a0 == b0 && a1 == b1) || (a0 == b1 && a1 == b0);
    float gd = 0.f; if (same) { const float w0 = (a0 == b0) ? ref[t * 4 + 2] : ref[t * 4 + 3], w1 = (a0 == b0) ? ref[t * 4 + 3] : ref[t * 4 + 2]; gd = fabsf(mine[t * 4 + 2] - w0) + fabsf(mine[t * 4 + 3] - w1); }
    atomicAdd(stat, same ? 0.f : 1.f); atomicAdd(stat + 1, 0.03f);
    atomicAdd(stat + 2, gd); atomicAdd(stat + 3, 1.0f);
}
__global__ void verdict(float* out, const float* stat, int nstage, size_t n) {
    int bad = 0;
    for (int k = 0; k < nstage; ++k) { const float d = stat[2 * k], r = stat[2 * k + 1]; float tol = 1e-3f; if (k == 7) tol = 1.0f;
        if (!(d <= tol * r)) { bad = k + 1; break; } }
    if (!bad) return;
    for (size_t i = (size_t)blockIdx.x * blockDim.x + threadIdx.x; i < n; i += (size_t)gridDim.x * blockDim.x) out[i] = (float)bad;
}
#endif

extern "C" void kernel_launch(void* const* d_in, const int* in_sizes, int n_in, void* d_out, int out_size, void* d_ws, size_t ws_size, hipStream_t stream) {
    static int grid = 0;
    if (grid == 0) {
        if (n_in != 15 || in_sizes[0] != T * D || out_size != T * D || ws_size < WS_NEED) { fprintf(stderr, "kernel_launch: unexpected problem (n_in %d, in0 %d, out %d, ws %zu)\n", n_in, n_in > 0 ? in_sizes[0] : -1, out_size, ws_size); grid = -1; return; }
        int dev = 0, cus = 0, per_cu = 0;
        if (hipGetDevice(&dev) != hipSuccess || hipDeviceGetAttribute(&cus, hipDeviceAttributeMultiprocessorCount, dev) != hipSuccess) { grid = -1; return; }
        if (hipFuncSetAttribute((const void*)fwd_kernel, hipFuncAttributeMaxDynamicSharedMemorySize, LDS_BYTES) != hipSuccess) { fprintf(stderr, "kernel_launch: hipFuncSetAttribute failed\n"); grid = -1; return; }
        if (hipOccupancyMaxActiveBlocksPerMultiprocessor(&per_cu, (const void*)fwd_kernel, NTHR, LDS_BYTES) != hipSuccess || per_cu < 1) { fprintf(stderr, "kernel_launch: occupancy query says %d\n", per_cu); }
        (void)hipGetLastError();
        grid = cus;
        if (grid != 256) fprintf(stderr, "kernel_launch: note: %d CUs\n", grid);
    }
    if (grid < 0) return;
    (void)hipMemsetAsync((char*)d_ws + WS_CTL, 0, CTL_ZERO_BYTES, stream);
    Args a{};
    for (int i = 0; i < 15; ++i) a.in[i] = (const float*)d_in[i];
    a.out = (float*)d_out; a.ws = (unsigned char*)d_ws;
#if DEBUG_CHECK
    {
        char* ws = (char*)d_ws; float* stat = (float*)(ws + WS_CTL) + CW_STAT;
        nv::Bufs B; B.h = (float*)(ws + WS_DBG); B.proj = (float*)(ws + WS_DBG + 8 * MiB); B.merged = (float*)(ws + WS_DBG + 64 * MiB); B.x2 = (float*)(ws + WS_DBG + 72 * MiB);
        float* nout = (float*)(ws + WS_DBG + 80 * MiB); float* nroute = (float*)(ws + WS_DBG + 88 * MiB);
        nv::run_seq(d_in, REF_B, B, nout, nroute, stream);
        const size_t ro = (size_t)REF_B * 2048 * 1024;
        for (int p = 0; p < NPHASES; ++p) {
            a.ph_lo = p; a.ph_hi = p + 1;
            hipLaunchKernelGGL(fwd_kernel, dim3(grid), dim3(NTHR), LDS_BYTES, stream, a);
            if (p == 0) hipLaunchKernelGGL(cmp_rows, dim3(256), dim3(256), 0, stream, (const void*)((const bf16_t*)(ws + WS_H) + ro), 1, (const float*)B.h, 2048, stat + 0);
            if (p == 1) hipLaunchKernelGGL(cmp_pqrv, dim3(256), dim3(256), 0, stream, (const bf16_t*)(ws + WS_P) + ro, (const bf16_t*)(ws + WS_Q) + ro, (const bf16_t*)(ws + WS_R) + ro, (const bf16_t*)(ws + WS_V) + ro, (const float*)B.proj, stat + 2);
            if (p == 2) hipLaunchKernelGGL(cmp_rows, dim3(256), dim3(256), 0, stream, (const void*)((const bf16_t*)(ws + WS_H) + ro), 1, (const float*)B.merged, 2048, stat + 10);
            if (p == 3) hipLaunchKernelGGL(cmp_rows, dim3(256), dim3(256), 0, stream, (const void*)((const bf16_t*)(ws + WS_H2) + ro), 1, (const float*)B.x2, 2048, stat + 12);
            if (p == 4) hipLaunchKernelGGL(cmp_route, dim3(8), dim3(256), 0, stream, (const float*)(ws + WS_ROUTE) + (size_t)REF_B * 2048 * 4, (const float*)nroute, stat + 14);
            if (p == 7) hipLaunchKernelGGL(cmp_rows, dim3(256), dim3(256), 0, stream, (const void*)((const float*)d_out + ro), 0, (const float*)nout, 2048, stat + 18);
        }
        hipLaunchKernelGGL(verdict, dim3(256), dim3(256), 0, stream, (float*)d_out, (const float*)stat, 10, (size_t)T * D);
    }
#else
#ifndef N_LAUNCH_PER_PHASE
#define N_LAUNCH_PER_PHASE 1
#endif
#ifndef PROBE_REPEAT
#define PROBE_REPEAT -1
#endif
    if (N_LAUNCH_PER_PHASE) { for (int p = 0; p < NPHASES; ++p) { a.ph_lo = p; a.ph_hi = p + 1; hipLaunchKernelGGL(fwd_kernel, dim3(grid), dim3(NTHR), LDS_BYTES, stream, a);
        if (p == PROBE_REPEAT && p == 4) (void)hipMemsetAsync((char*)d_ws + WS_CTL + CW_GCNT * 4, 0, 256, stream);
        if (p == PROBE_REPEAT) hipLaunchKernelGGL(fwd_kernel, dim3(grid), dim3(NTHR), LDS_BYTES, stream, a); } }
    else { a.ph_lo = 0; a.ph_hi = NPHASES; hipLaunchKernelGGL(fwd_kernel, dim3(grid), dim3(NTHR), LDS_BYTES, stream, a); }
#endif
}
```

```cpp
#include <hip/hip_runtime.h>
#include <cstdio>
#include <cstdint>
#define DEBUG_CHECK 0
#define N_LAUNCH_PER_PHASE 0
#define GAS __attribute__((address_space(1)))
#define LAS __attribute__((address_space(3)))
typedef unsigned short bf16_t;
typedef short bf16x8 __attribute__((ext_vector_type(8)));
typedef float f32x4 __attribute__((ext_vector_type(4)));
typedef float f32x2 __attribute__((ext_vector_type(2)));
typedef unsigned u32x4 __attribute__((ext_vector_type(4)));
typedef unsigned u32x2 __attribute__((ext_vector_type(2)));
typedef unsigned short u16x4 __attribute__((ext_vector_type(4)));

constexpr int T = 16384, D = 1024, NP = 7168, NE = 64, DE = 512, SEQ = 2048, LCAP = 16384;
constexpr float EPS = 1e-6f;
constexpr int NWAVES = 8, NTHR = 512;

#define RLX_AGENT __ATOMIC_RELAXED, __HIP_MEMORY_SCOPE_AGENT
#define LDS_WAIT() asm volatile("s_waitcnt lgkmcnt(0)" ::: "memory")
#define VM_WAIT() asm volatile("s_waitcnt vmcnt(0)" ::: "memory")

__device__ __forceinline__ int lane_id_fresh() { int l; asm volatile("v_mbcnt_lo_u32_b32 %0, -1, 0\n\tv_mbcnt_hi_u32_b32 %0, -1, %0" : "=v"(l)); return l; }
__device__ __forceinline__ unsigned cvt_pk_bf16(float lo, float hi) { unsigned r; asm volatile("v_cvt_pk_bf16_f32 %0, %1, %2" : "=v"(r) : "v"(lo), "v"(hi)); return r; }
typedef int v4i_t __attribute__((ext_vector_type(4)));
typedef int v8i_t __attribute__((ext_vector_type(8)));
__device__ __forceinline__ v8i_t cat8(bf16x8 lo, bf16x8 hi) { const v4i_t a = __builtin_bit_cast(v4i_t, lo), b = __builtin_bit_cast(v4i_t, hi); return __builtin_shufflevector(a, b, 0, 1, 2, 3, 4, 5, 6, 7); }
__device__ __forceinline__ unsigned pk4_fp8(float a, float b, float c, float d) { unsigned w = 0u; w = __builtin_amdgcn_cvt_pk_fp8_f32(a, b, w, false); w = __builtin_amdgcn_cvt_pk_fp8_f32(c, d, w, true); return w; }
__device__ __forceinline__ float bf_lo(unsigned w) { return __uint_as_float(w << 16); }
__device__ __forceinline__ float bf_hi(unsigned w) { return __uint_as_float(w & 0xffff0000u); }
__device__ __forceinline__ float wave_sum(float v) {
#pragma unroll
    for (int o = 1; o < 64; o <<= 1) v += __shfl_xor(v, o);
    return v;
}
__device__ __forceinline__ float fast_sigm(float y) { return __builtin_amdgcn_rcpf(1.0f + __builtin_amdgcn_exp2f(-1.4426950408889634f * y)); }
__device__ __forceinline__ float fast_gelu(float x) { return x * fast_sigm(1.5957691216057308f * (x + 0.044715f * x * x * x)); }
#define GK1 (-2.3022081986f)
#define GK2 (-0.1029432396f)
__device__ __forceinline__ f32x2 exp2_pk(f32x2 a) { f32x2 r; r.x = __builtin_amdgcn_exp2f(a.x); r.y = __builtin_amdgcn_exp2f(a.y); return r; }
__device__ __forceinline__ f32x2 rcp_pk(f32x2 a) { f32x2 r; r.x = __builtin_amdgcn_rcpf(a.x); r.y = __builtin_amdgcn_rcpf(a.y); return r; }
__device__ __forceinline__ f32x2 gelu_sig_pk(f32x2 x, f32x2 y) {
    const f32x2 t = x * x, p = t * GK2 + GK1, ea = exp2_pk(x * p), ey = exp2_pk(y * (-1.4426950408889634f));
    return x * rcp_pk((ea + 1.0f) * (ey + 1.0f));
}
__device__ __forceinline__ f32x2 mul_sig_pk(f32x2 x, f32x2 y) { return x * rcp_pk(exp2_pk(y * (-1.4426950408889634f)) + 1.0f); }
__device__ __forceinline__ f32x2 gelu_pk2(f32x2 x) { const f32x2 t = x * x, p = t * GK2 + GK1; return x * rcp_pk(exp2_pk(x * p) + 1.0f); }

#define XB_TMO      128
#define XB_XCNT(j)  (256  + 64 * (j))
#define XB_XSUB(j)  (1280 + 64 * (j))
#define XB_XGEN(j)  (2304 + 64 * (j))
#define XB_TOP      3328
#define XB_TOPGEN   3392
#define XCD_BAR_WORDS 3456
#define XB_SPIN_CAP (1u << 18)
__device__ __forceinline__ unsigned xb_ld(unsigned* p)              { return __hip_atomic_load(p, __ATOMIC_RELAXED, __HIP_MEMORY_SCOPE_AGENT); }
__device__ __forceinline__ unsigned xb_add(unsigned* p, unsigned v) { return __hip_atomic_fetch_add(p, v, __ATOMIC_RELAXED, __HIP_MEMORY_SCOPE_AGENT); }
__device__ __forceinline__ unsigned xb_xcc_id() { return (unsigned)__builtin_amdgcn_s_getreg((3 << 11) | 20) & 0xFu; }
#define XB_SPIN(cond, bar) do { unsigned _sp = 0; while (cond) { __builtin_amdgcn_s_sleep(1); \
    if ((++_sp & 255u) == 0u) { if (xb_ld(&(bar)[XB_TMO])) break; if (_sp > XB_SPIN_CAP) { atomicAdd(&(bar)[XB_TMO], 1u); break; } } } } while (0)
struct XcdBarrier { unsigned* bar; unsigned x; volatile LAS unsigned* st; int wave; };
__device__ __forceinline__ XcdBarrier xcd_barrier_post(unsigned* bar, volatile LAS unsigned* st) {
    XcdBarrier b; b.bar = bar; b.x = xb_xcc_id(); b.st = st; b.wave = __builtin_amdgcn_readfirstlane((int)(threadIdx.x >> 6));
    if (threadIdx.x == 0) (void)xb_add(&bar[XB_XCNT(b.x)], 1u);
    return b;
}
__device__ __forceinline__ void xcd_barrier_complete(unsigned* bar, unsigned x, unsigned& nloc, unsigned& nx) {
    const unsigned G = gridDim.x * gridDim.y * gridDim.z;
    unsigned sum, cnt, mine, sp = 0u;
    for (;;) {
        sum = 0u; cnt = 0u; mine = 0u;
#pragma unroll
        for (unsigned j = 0; j < 16; ++j) { const unsigned c = xb_ld(&bar[XB_XCNT(j)]); sum += c; cnt += (c > 0u) ? 1u : 0u; mine = (j == x) ? c : mine; }
        if (sum == G) break;
        __builtin_amdgcn_s_sleep(1);
        if ((++sp & 255u) == 0u) { if (xb_ld(&bar[XB_TMO])) break; if (sp > XB_SPIN_CAP) { atomicAdd(&bar[XB_TMO], 1u); break; } }
    }
    nloc = mine > 0u ? mine : 1u; nx = cnt > 0u ? cnt : 1u;
}
__device__ __forceinline__ void xcd_barrier(const XcdBarrier& b) {
    asm volatile("s_waitcnt vmcnt(0)" ::: "memory");
    __syncthreads();
    if (b.wave == 0 && lane_id_fresh() == 0) {
        unsigned* bar = b.bar;
        __builtin_amdgcn_s_waitcnt(0);
        unsigned nloc = b.st[0], nx = b.st[1];
        if (nloc == 0u) { xcd_barrier_complete(bar, b.x, nloc, nx); b.st[0] = nloc; b.st[1] = nx; }
        const unsigned old = xb_add(&bar[XB_XSUB(b.x)], 1u);
        const unsigned gen = old / nloc;
        if (old + 1u == (gen + 1u) * nloc) {
            __builtin_amdgcn_fence(__ATOMIC_RELEASE, "agent");
            asm volatile("s_waitcnt vmcnt(0)" ::: "memory");
            const unsigned og = xb_add(&bar[XB_TOP], 1u);
            const unsigned tg = og / nx;
            if (og + 1u == (tg + 1u) * nx) xb_add(&bar[XB_TOPGEN], 1u);
            else XB_SPIN(xb_ld(&bar[XB_TOPGEN]) == tg, bar);
            __builtin_amdgcn_fence(__ATOMIC_ACQUIRE, "agent");
            xb_add(&bar[XB_XGEN(b.x)], 1u);
            asm volatile("s_waitcnt vmcnt(0)" ::: "memory");
        } else {
            XB_SPIN(xb_ld(&bar[XB_XGEN(b.x)]) == gen, bar);
            __builtin_amdgcn_fence(__ATOMIC_ACQUIRE, "agent");
            asm volatile("s_waitcnt vmcnt(0)" ::: "memory");
        }
    }
    __syncthreads();
}

namespace pg8 {
constexpr int BM = 256, BK = 64, HALF = 128, HTB = HALF * BK * 2, STAGE_BYTES = 8 * HTB, NXCD = 8, WGM = 8;
__host__ __device__ __forceinline__ int lds_byte(int r, int c) { const int st = (r >> 4) * 2 + (c >> 5), rr = r & 15, cc = c & 31, ob = rr * 64 + cc * 2; return st * 1024 + (ob ^ (((ob >> 9) & 1) << 5)); }
__host__ __device__ __forceinline__ void stage_rc(int b, int& R, int& C) { const int st = b / 1024, sb = b % 1024, swz = sb ^ (((sb >> 9) & 1) << 5); R = (st >> 1) * 16 + swz / 64; C = (st & 1) * 32 + (swz % 64) / 2; }
__host__ __device__ __forceinline__ int perm32(int rho) { const int n = rho >> 4, i = rho & 15; return 8 * (i >> 2) + 4 * n + (i & 3); }
__host__ __device__ __forceinline__ int xcd_remap(int L, int nwg) { const int q = nwg / NXCD, r = nwg % NXCD, xcd = L % NXCD, off = L / NXCD; return (xcd < r ? xcd * (q + 1) : r * (q + 1) + (xcd - r) * q) + off; }

struct Unit { const char* a; const char* b; int m0, n0, e, cnt, lb; };

struct StaticOrder {
    int nM, nN, nwg, G, c;
    __host__ __device__ void init(int M, int N, int G_, int c_) { nM = M / BM; nN = N / BM; nwg = nM * nN; G = G_; c = c_; }
    __host__ __device__ bool next(int i, int& pm, int& pn) const {
        const long L = (long)i * G + c; if (L >= nwg) return false;
        const int wgid = xcd_remap((int)L, nwg);
        const int nig = WGM * nN, gid = wgid / nig, fm = gid * WGM, gsz = (nM - fm) < WGM ? (nM - fm) : WGM;
        pm = fm + ((wgid % nig) % gsz); pn = (wgid % nig) / gsz; return true;
    }
};

#ifndef TSTAT
#define TSTAT 0
#endif
template <class P>
__device__ __forceinline__ void gemm_phase(LAS unsigned char* lds, const P& S, int wid, float* tstat = nullptr) {
#if TSTAT
    unsigned long long ts_k = 0, ts_e = 0, ts_g = 0, ts_n = 0, tsA = 0, tsB = 0, tsC = 0;
#endif
    constexpr int K = P::K, nt = K / BK;
    const int lane = lane_id_fresh(), tid = wid * 64 + lane, wr = wid >> 2, wc = wid & 3, fr = lane & 15, fq = lane >> 4;
    unsigned voffB[2];
#pragma unroll
    for (int i = 0; i < 2; ++i) { int R, C; stage_rc(tid * 16 + i * 8192, R, C); const int Rb = P::PERM ? ((R & ~31) + perm32(R & 31)) : R; voffB[i] = (unsigned)(Rb * K + C) * 2u; }
    constexpr size_t kstep = (size_t)(BK * 2);
    constexpr size_t hstep = (size_t)HALF * K * 2;
    const unsigned ldsw = (unsigned)wid * 1024u;
    const int aoff = lds_byte(wr * 64 + fr, fq * 8), boff = lds_byte(wc * 32 + fr, fq * 8);
#define PG8_SA(b, h) (((b) * 2 + (h)) * HTB)
#define PG8_SB(b, h) ((4 + (b) * 2 + (h)) * HTB)
#define PG8_STAGE_B(bufoff, gbase) do { _Pragma("unroll") for (int _i = 0; _i < 2; ++_i) { unsigned o_ = voffB[_i]; asm volatile("" : "+v"(o_)); \
        __builtin_amdgcn_global_load_lds((const unsigned*)((const char*)(gbase) + o_), (LAS unsigned*)(lds + (bufoff) + ldsw + _i * 8192), 16, 0, 0); } } while (0)
#define PG8_STAGE_A(bufoff, gbase, offs, h) do { _Pragma("unroll") for (int _i = 0; _i < 2; ++_i) { unsigned o_ = (offs)[h][_i]; asm volatile("" : "+v"(o_)); \
        __builtin_amdgcn_global_load_lds((const unsigned*)((const char*)(gbase) + o_), (LAS unsigned*)(lds + (bufoff) + ldsw + _i * 8192), 16, 0, 0); } } while (0)
#define PG8_LDA(dst, b, h) do { _Pragma("unroll") for (int m = 0; m < 4; ++m) _Pragma("unroll") for (int k = 0; k < 2; ++k) dst[m][k] = *(const LAS bf16x8*)(lds + PG8_SA(b, h) + aoff + m * 2048 + k * 1024); } while (0)
#define PG8_LDB(dst, b, h) do { _Pragma("unroll") for (int n = 0; n < 2; ++n) _Pragma("unroll") for (int k = 0; k < 2; ++k) dst[n][k] = *(const LAS bf16x8*)(lds + PG8_SB(b, h) + boff + n * 2048 + k * 1024); } while (0)
#define PG8_MMA(ai, bj, At, Bt) do { __builtin_amdgcn_s_setprio(1); _Pragma("unroll") for (int m = 0; m < 4; ++m) _Pragma("unroll") for (int n = 0; n < 2; ++n) _Pragma("unroll") for (int k = 0; k < 2; ++k) \
        acc[ai][bj][m][n] = __builtin_amdgcn_mfma_f32_16x16x32_bf16(Bt[n][k], At[m][k], acc[ai][bj][m][n], 0, 0, 0); __builtin_amdgcn_s_setprio(0); } while (0)
#define PG8_MMA8(ai, bj, At, Bt) do { __builtin_amdgcn_s_setprio(1); _Pragma("unroll") for (int m = 0; m < 4; ++m) _Pragma("unroll") for (int n = 0; n < 2; ++n) \
        acc[ai][bj][m][n] = __builtin_amdgcn_mfma_scale_f32_16x16x128_f8f6f4(cat8(Bt[n][0], Bt[n][1]), cat8(At[m][0], At[m][1]), acc[ai][bj][m][n], 0, 0, 0, 0x7f7f7f7f, 0, 0x7f7f7f7f); __builtin_amdgcn_s_setprio(0); } while (0)
#define PG8_MM(ai, bj, At, Bt) do { if constexpr (P::FP8) PG8_MMA8(ai, bj, At, Bt); else PG8_MMA(ai, bj, At, Bt); } while (0)
#define PG8_WAIT_V(n) asm volatile("s_waitcnt vmcnt(" #n ")" ::: "memory")
#define PG8_WAIT_L(n) asm volatile("s_waitcnt lgkmcnt(" #n ")" ::: "memory")
#define PG8_BAR __builtin_amdgcn_s_barrier()
#define PG8_SCHED __builtin_amdgcn_sched_barrier(0)
    Unit cur, nxt; int ui = 0;
    if (!S.next(0, cur)) return;
    f32x4 acc[2][2][4][2];
#pragma unroll
    for (int a = 0; a < 2; ++a)
#pragma unroll
        for (int b = 0; b < 2; ++b)
#pragma unroll
            for (int m = 0; m < 4; ++m)
#pragma unroll
                for (int n = 0; n < 2; ++n) acc[a][b][m][n] = (f32x4){0.f, 0.f, 0.f, 0.f};
    bf16x8 At[4][2], B0[2][2], B1[2][2];
    unsigned vAc[2][2];
#pragma unroll
    for (int h = 0; h < 2; ++h)
#pragma unroll
        for (int i = 0; i < 2; ++i) { int R, C; stage_rc(tid * 16 + i * 8192, R, C);
            if constexpr (P::GATHER) vAc[h][i] = S.row_off(cur, h * HALF + R) + (unsigned)C * 2u;
            else vAc[h][i] = (unsigned)((h * HALF + R) * K + C) * 2u;
        }
    const char* cA = cur.a; const char* cB = cur.b;
    PG8_STAGE_B(PG8_SB(0, 0), cB); PG8_STAGE_B(PG8_SB(0, 1), cB + hstep); PG8_STAGE_A(PG8_SA(0, 0), cA, vAc, 0); PG8_STAGE_A(PG8_SA(0, 1), cA, vAc, 1);
    if (wr == 1) PG8_BAR;
    PG8_WAIT_V(2); PG8_BAR;
    PG8_STAGE_B(PG8_SB(1, 0), cB + kstep); PG8_STAGE_A(PG8_SA(1, 0), cA + kstep, vAc, 0); PG8_STAGE_B(PG8_SB(1, 1), cB + hstep + kstep);
    PG8_WAIT_V(6); PG8_BAR;
    for (;;) {
#if TSTAT
        if (tstat) { tsA = __builtin_amdgcn_s_memrealtime(); if (ts_n) ts_g += tsA - tsC; }
#endif
        const bool has_next = S.next(ui + 1, nxt);
        const char* nA = has_next ? nxt.a : cA; const char* nB = has_next ? nxt.b : cB;

#pragma clang loop unroll(disable)
        for (int t = 0; t < nt; t += 2) {
            const bool last = (t == nt - 2);
            const char* a1 = cA + (size_t)(t + 1) * kstep;
            const char* a2 = last ? nA : cA + (size_t)(t + 2) * kstep; const char* b2 = last ? nB : cB + (size_t)(t + 2) * kstep;
            const char* a3 = a2 + kstep; const char* b3 = b2 + kstep;
            PG8_LDB(B0, 0, 0); PG8_LDB(B1, 0, 1); PG8_SCHED; PG8_LDA(At, 0, 0); PG8_STAGE_A(PG8_SA(1, 1), a1, vAc, 1);
            if constexpr (P::GATHER) { if (last && has_next) {
#pragma unroll
                for (int h = 0; h < 2; ++h)
#pragma unroll
                    for (int i = 0; i < 2; ++i) { int R, C; stage_rc((wid * 64 + lane_id_fresh()) * 16 + i * 8192, R, C); vAc[h][i] = S.row_off(nxt, h * HALF + R) + (unsigned)C * 2u; } } }
            PG8_WAIT_V(8); PG8_WAIT_L(0); PG8_BAR; PG8_MM(0, 0, At, B0); PG8_MM(0, 1, At, B1); PG8_BAR; PG8_SCHED;
            PG8_LDA(At, 0, 1); PG8_STAGE_B(PG8_SB(0, 0), b2); PG8_STAGE_B(PG8_SB(0, 1), b2 + hstep); PG8_STAGE_A(PG8_SA(0, 0), a2, vAc, 0);
            PG8_WAIT_V(8); PG8_WAIT_L(0); PG8_BAR; PG8_MM(1, 0, At, B0); PG8_MM(1, 1, At, B1); PG8_BAR; PG8_SCHED;
            PG8_LDB(B0, 1, 0); PG8_LDB(B1, 1, 1); PG8_SCHED; PG8_LDA(At, 1, 0); PG8_STAGE_A(PG8_SA(0, 1), a2, vAc, 1);
            PG8_WAIT_V(8); PG8_WAIT_L(0); PG8_BAR; PG8_MM(0, 0, At, B0); PG8_MM(0, 1, At, B1); PG8_BAR; PG8_SCHED;
            PG8_LDA(At, 1, 1); PG8_STAGE_B(PG8_SB(1, 0), b3); PG8_STAGE_B(PG8_SB(1, 1), b3 + hstep); PG8_STAGE_A(PG8_SA(1, 0), a3, vAc, 0);
            PG8_WAIT_V(8); PG8_WAIT_L(0); PG8_BAR; PG8_MM(1, 0, At, B0); PG8_MM(1, 1, At, B1); PG8_BAR; PG8_SCHED;
        }
#if TSTAT
        if (tstat) tsB = __builtin_amdgcn_s_memrealtime();
#endif
        if (wr == 0) PG8_BAR;
        if constexpr (!P::AFTER_DRAIN) { const int l_ = lane_id_fresh();
            S.epi(acc, cur, wr, wc, l_ & 15, l_ >> 4); }
#if TSTAT
        if (tstat) { tsC = __builtin_amdgcn_s_memrealtime(); ts_k += tsB - tsA; ts_e += tsC - tsB; ts_n += 1; }
#endif
        if (!has_next) break;
#pragma unroll
        for (int a = 0; a < 2; ++a)
#pragma unroll
            for (int b = 0; b < 2; ++b)
#pragma unroll
                for (int m = 0; m < 4; ++m)
#pragma unroll
                    for (int n = 0; n < 2; ++n) acc[a][b][m][n] = (f32x4){0.f, 0.f, 0.f, 0.f};
        cur = nxt; cA = nA; cB = nB; ++ui;
        if (wr == 1) PG8_BAR;
    }
    PG8_WAIT_V(0);
    PG8_BAR;
    if constexpr (P::AFTER_DRAIN) { const int l_ = lane_id_fresh(); S.epi_drain(acc, cur, wr, wc, l_ & 15, l_ >> 4, lds); }
#if TSTAT
    if (tstat && tid == 0) { atomicAdd(tstat + 0, (float)ts_k); atomicAdd(tstat + 1, (float)ts_e); atomicAdd(tstat + 2, (float)ts_g); atomicAdd(tstat + 3, (float)ts_n); }
#endif
#undef PG8_SA
#undef PG8_SB
#undef PG8_STAGE_A
#undef PG8_STAGE_B
#undef PG8_LDA
#undef PG8_LDB
#undef PG8_MMA
#undef PG8_MMA8
#undef PG8_MM
#undef PG8_WAIT_V
#undef PG8_WAIT_L
#undef PG8_BAR
#undef PG8_SCHED
}
}
constexpr size_t MiB = (size_t)1 << 20;
constexpr size_t WS_CTL = 0, CTL_ZERO_BYTES = 1 * MiB;
constexpr size_t WS_BT1 = 2 * MiB;
constexpr size_t WS_BT2 = 16 * MiB;
constexpr size_t WS_WR = 18 * MiB;
constexpr size_t WS_WSB = 19 * MiB;
constexpr size_t WS_BTGU = 20 * MiB;
constexpr size_t WS_BTD = 148 * MiB;
constexpr size_t WS_H = 212 * MiB;
constexpr size_t WS_C = 244 * MiB;
constexpr size_t WS_P = WS_C, WS_Q = WS_C + 32 * MiB, WS_R = WS_C + 64 * MiB, WS_V = WS_C + 96 * MiB;
constexpr size_t WS_H2 = WS_C, WS_HID = WS_C + 32 * MiB, WS_Y = WS_C + 96 * MiB;
constexpr size_t WS_X8 = WS_C + 64 * MiB;
constexpr size_t WS_PLG = WS_Y;
constexpr int PLW = 84;
constexpr size_t WS_LTOK = 404 * MiB, WS_LW = 408 * MiB, WS_LRS = 412 * MiB;
constexpr size_t WS_X2 = 420 * MiB;
constexpr size_t WS_ROUTE = 416 * MiB;
constexpr size_t WS_ROUTE2 = WS_ROUTE + 512 * 1024;
constexpr size_t WS_DBG = 417 * MiB;
constexpr size_t WS_NEED = 512 * MiB;
constexpr int CW_TMO = 0, CW_GCNT = 1024, CW_STAT = 2048, CW_BAR = 4096;
static_assert((CW_BAR + XCD_BAR_WORDS) * 4 <= (int)CTL_ZERO_BYTES, "ctl");
#if TSTAT
#define TS_SEL(k) ((k) == TS_PHASE ? (float*)(F.ctl + CW_STAT) : (float*)nullptr)
#else
#define TS_SEL(k) ((float*)nullptr)
#endif
constexpr int RING_BYTES = 131072;
constexpr int TAB_OFF = RING_BYTES;
constexpr int PS_OFF = TAB_OFF + 8192;
constexpr int CN_OFF = PS_OFF + 320;
constexpr int CS_OFF = CN_OFF + 256;
constexpr int MISC_OFF = CS_OFF + 256;
constexpr int LDS_BYTES = 147456;
static_assert(MISC_OFF + 16 <= LDS_BYTES, "lds");
constexpr int MAXU = 4;

struct Frame {
    LAS unsigned char* lds; int tid, lane, wave, G, bid;
    unsigned* ctl;
    const float *x, *g_mix, *w_in, *w_s, *b_s, *g_sgu, *w_conv, *w_out, *g_ffn, *w_rg, *w_re, *wg, *wu, *wd, *g_final;
    float* out; float* x2; unsigned char* ws;
};

struct TJob { const float* src; bf16_t* dst; int ld, ldd; };
constexpr int NJ_IN = 16 * 56, NJ_OUT = 16 * 8, NJ_GU = 64 * 16 * 8, NJ_DN = 64 * 8 * 8, NJOBS = NJ_IN + NJ_OUT + NJ_GU + NJ_DN;
__device__ __forceinline__ TJob tjob(const Frame& F, int j) {
    TJob J;
    if (j < NJ_IN) { const int kt = j / 56, nt = j % 56, pn = nt >> 1, bj = nt & 1; int sc;
        if (pn < 8) sc = bj ? 5120 + 128 * pn : 128 * pn;
        else if (pn < 16) sc = bj ? 6144 + 128 * (pn - 8) : 2048 + 128 * (pn - 8);
        else if (pn < 24) sc = bj ? 4096 + 128 * (pn - 16) : 3072 + 128 * (pn - 16);
        else sc = 1024 + 256 * (pn - 24) + 128 * bj;
        J.src = F.w_in + (size_t)(kt * 64) * NP + sc; J.ld = NP; J.dst = (bf16_t*)(F.ws + WS_BT1) + (size_t)(nt * 128) * 1024 + kt * 64; J.ldd = 1024; return J; }
    j -= NJ_IN;
    if (j < NJ_OUT) { const int kt = j / 8, nt = j % 8;
        J.src = F.w_out + (size_t)(kt * 64) * D + nt * 128; J.ld = D; J.dst = (bf16_t*)(F.ws + WS_BT2) + (size_t)(nt * 128) * 1024 + kt * 64; J.ldd = 1024; return J; }
    j -= NJ_OUT;
    if (j < NJ_GU) { const int e = j / 128, r = j % 128, kt = r / 8, nt = r % 8, jj = nt >> 1, bj = nt & 1;
        J.src = (bj ? F.wu : F.wg) + (size_t)e * 1024 * 512 + (size_t)(kt * 64) * 512 + jj * 128; J.ld = 512;
        J.dst = (bf16_t*)(F.ws + WS_BTGU) + ((size_t)e * 1024 + jj * 256 + bj * 128) * 1024 + kt * 64; J.ldd = 1024; return J; }
    j -= NJ_GU;
    { const int e = j / 64, r = j % 64, kt = r / 8, nt = r % 8;
      J.src = F.wd + (size_t)e * 512 * 1024 + (size_t)(kt * 64) * 1024 + nt * 128; J.ld = 1024;
      J.dst = (bf16_t*)(F.ws + WS_BTD) + ((size_t)e * 1024 + nt * 128) * 512 + kt * 64; J.ldd = 512; return J; }
}
__device__ __forceinline__ unsigned off_b(unsigned row, unsigned ch) { return 256u * row + 16u * (ch ^ (((row & 3) << 2) | ((row >> 2) & 3))); }
__device__ __forceinline__ unsigned tr_read_addr_16(unsigned lane, unsigned c, unsigned ks, unsigned t) {
    const unsigned g = lane >> 4, q = (lane & 15) >> 2, p = lane & 3;
    return off_b(32 * ks + 8 * g + 4 * t + q, 2 * c + (p >> 1)) + 8 * (p & 1);
}
__device__ __forceinline__ void convert_jobs(const Frame& F, int jlo, int jhi) {
    LAS float* tile0 = (LAS float*)F.lds;
    const int kr = F.tid >> 5, n4 = (F.tid & 31) * 4;
    f32x4 v0[4], v1[4], v2[4];
#define CJ_LOAD(v, jj) do { if ((jj) < jhi) { const TJob J_ = tjob(F, (jj)); _Pragma("unroll") for (int p = 0; p < 4; ++p) v[p] = __builtin_nontemporal_load((const f32x4*)(J_.src + (size_t)(kr + 16 * p) * J_.ld + n4)); } } while (0)
#define CJ_STEP(v, jj, par) do { if ((jj) < jhi) { const TJob J_ = tjob(F, (jj)); LAS float* tile = tile0 + (par) * (64 * 129); \
        _Pragma("unroll") for (int p = 0; p < 4; ++p) { LAS float* d = tile + (kr + 16 * p) * 129 + n4; d[0] = v[p][0]; d[1] = v[p][1]; d[2] = v[p][2]; d[3] = v[p][3]; } \
        CJ_LOAD(v, (jj) + 3 * F.G); \
        __syncthreads(); \
        _Pragma("unroll") for (int rep = 0; rep < 2; ++rep) { const int n = (F.tid >> 3) + 64 * rep, k8 = (F.tid & 7) * 8; const LAS float* s_ = tile + k8 * 129 + n; \
            u32x4 o; o.x = cvt_pk_bf16(s_[0], s_[129]); o.y = cvt_pk_bf16(s_[2 * 129], s_[3 * 129]); o.z = cvt_pk_bf16(s_[4 * 129], s_[5 * 129]); o.w = cvt_pk_bf16(s_[6 * 129], s_[7 * 129]); \
            *(u32x4*)(J_.dst + (size_t)n * J_.ldd + k8) = o; } } } while (0)
    int j = jlo + F.bid;
    CJ_LOAD(v0, j); CJ_LOAD(v1, j + F.G); CJ_LOAD(v2, j + 2 * F.G);
    for (; j < jhi; j += 6 * F.G) {
        CJ_STEP(v0, j, 0); CJ_STEP(v1, j + F.G, 1); CJ_STEP(v2, j + 2 * F.G, 0);
        CJ_STEP(v0, j + 3 * F.G, 1); CJ_STEP(v1, j + 4 * F.G, 0); CJ_STEP(v2, j + 5 * F.G, 1);
    }
    __syncthreads();
#undef CJ_LOAD
#undef CJ_STEP
}
constexpr float WSCALE = 64.0f, WSCALE_INV = 1.0f / 64.0f;
constexpr int NI_GU = 64 * 8 * 32, NI_DN = 64 * 4 * 32;
constexpr int P4_ITEMS = 12;
__device__ __forceinline__ void xitem(const Frame& F, int id, const float*& src, int& ld, unsigned char*& dst, int& ldd, int& k0) {
    if (id < NI_GU) { const int e = id >> 8, r = id & 255, kt = r >> 5, nb = r & 31, jj = nb >> 3, bj = (nb >> 2) & 1, sub = nb & 3;
        src = (bj ? F.wu : F.wg) + (size_t)e * 1024 * 512 + (size_t)(kt * 128) * 512 + jj * 128 + sub * 32; ld = 512; k0 = kt * 128;
        dst = F.ws + WS_BTGU + ((size_t)e * 1024 + nb * 32) * 1024 + kt * 128; ldd = 1024; }
    else { id -= NI_GU; const int e = id >> 7, r = id & 127, kt = r >> 5, nb = r & 31;
        src = F.wd + (size_t)e * 512 * 1024 + (size_t)(kt * 128) * 1024 + nb * 32; ld = 1024; k0 = -1;
        dst = F.ws + WS_BTD + ((size_t)e * 1024 + nb * 32) * 512 + kt * 128; ldd = 512; }
}
template <bool SYNC = true>
__device__ __forceinline__ void convert_experts_wave(const Frame& F, int item_lo, int item_hi, int widx, int wcnt) {
    LAS float* scr = (LAS float*)(F.lds + F.wave * 16896);
    const int gw = item_lo + widx, NGW = wcnt; const int NITEMS_X = item_hi;
    const int lk = F.lane >> 5, ln = F.lane & 31;
    const int c16 = F.lane & 7, nr = F.lane >> 3;
    float va[64], vb[64];
#define XI_LOAD(v, id) do { if ((id) < NITEMS_X) { const float* s_; int ld_; unsigned char* d_; int ldd_, k0_; xitem(F, (id), s_, ld_, d_, ldd_, k0_); \
        const __amdgpu_buffer_rsrc_t rs_ = __builtin_amdgcn_make_buffer_rsrc((void*)s_, (short)0, 0x7fffffff, 0x00020000); const int vo_ = (lk * ld_ + ln) * 4; \
        _Pragma("unroll") for (int i = 0; i < 64; ++i) v[i] = __builtin_bit_cast(float, __builtin_amdgcn_raw_buffer_load_b32(rs_, vo_, i * 8 * ld_, 2  )); } } while (0)
#define XI_STEP(v, id) do { if ((id) < NITEMS_X) { const float* s_; int ld_; unsigned char* d_; int ldd_, k0_; xitem(F, (id), s_, ld_, d_, ldd_, k0_); \
        _Pragma("unroll") for (int i = 0; i < 64; ++i) scr[(2 * i + lk) * 33 + ln] = v[i]; \
        XI_LOAD(v, (id) + 2 * NGW); \
        f32x4 g_[4]; _Pragma("unroll") for (int q = 0; q < 4; ++q) { g_[q] = (f32x4){WSCALE, WSCALE, WSCALE, WSCALE}; if (k0_ >= 0) g_[q] = *(const f32x4*)(F.g_ffn + k0_ + 16 * c16 + 4 * q) * WSCALE; }     \
        _Pragma("unroll") for (int j = 0; j < 4; ++j) { const int n = nr + 8 * j; const LAS float* t_ = scr + (16 * c16) * 33 + n; u32x4 o; \
            o.x = pk4_fp8(t_[0] * g_[0][0], t_[33] * g_[0][1], t_[2 * 33] * g_[0][2], t_[3 * 33] * g_[0][3]); o.y = pk4_fp8(t_[4 * 33] * g_[1][0], t_[5 * 33] * g_[1][1], t_[6 * 33] * g_[1][2], t_[7 * 33] * g_[1][3]); \
            o.z = pk4_fp8(t_[8 * 33] * g_[2][0], t_[9 * 33] * g_[2][1], t_[10 * 33] * g_[2][2], t_[11 * 33] * g_[2][3]); o.w = pk4_fp8(t_[12 * 33] * g_[3][0], t_[13 * 33] * g_[3][1], t_[14 * 33] * g_[3][2], t_[15 * 33] * g_[3][3]); \
            __builtin_nontemporal_store(o, (u32x4*)(d_ + (size_t)n * ldd_ + 16 * c16)); } } } while (0)
    int id = gw;
    XI_LOAD(va, id); XI_LOAD(vb, id + NGW);
    for (; id < NITEMS_X; id += 2 * NGW) { XI_STEP(va, id); XI_STEP(vb, id + NGW); }
#undef XI_LOAD
#undef XI_STEP
    if (SYNC) __syncthreads();
}
__device__ __forceinline__ void phase_prologue(const Frame& F) {
    convert_jobs(F, 0, NJ_IN + NJ_OUT);
    { bf16_t* hi = (bf16_t*)(F.ws + WS_WR); bf16_t* lo = hi + 80 * 1024;
      for (int i = F.bid * NTHR + F.tid; i < 80 * 1024; i += F.G * NTHR) { const int jj = i >> 10, c = i & 1023;
          float w = 0.f; if (jj < 64) w = F.w_re[c * 64 + jj] * F.g_ffn[c]; else if (jj < 72) w = F.w_rg[c * 8 + (jj - 64)] * F.g_ffn[c];
          const unsigned h = cvt_pk_bf16(w, 0.f) & 0xffffu; const float r = w - __uint_as_float(h << 16);
          hi[i] = (bf16_t)h; lo[i] = (bf16_t)(cvt_pk_bf16(r, 0.f) & 0xffffu); } }
    { bf16_t* o = (bf16_t*)(F.ws + WS_WSB);
      for (int i = F.bid * NTHR + F.tid; i < 8 * 128 * 128; i += F.G * NTHR) o[i] = (bf16_t)(cvt_pk_bf16(F.w_s[i], 0.f) & 0xffffu); }
    { bf16_t* H = (bf16_t*)(F.ws + WS_H);
      f32x4 g[4];
#pragma unroll
      for (int q = 0; q < 4; ++q) g[q] = *(const f32x4*)(F.g_mix + 4 * F.lane + 256 * q);
      for (int row = F.bid * NWAVES + F.wave; row < T; row += F.G * NWAVES) {
          const float* xr = F.x + (size_t)row * D + 4 * F.lane; f32x4 a[4]; float s = 0.f;
#pragma unroll
          for (int q = 0; q < 4; ++q) { a[q] = *(const f32x4*)(xr + 256 * q); s += (a[q][0] * a[q][0] + a[q][1] * a[q][1]) + (a[q][2] * a[q][2] + a[q][3] * a[q][3]); }
          const float r = 1.0f / sqrtf(wave_sum(s) * (1.0f / D) + EPS);
#pragma unroll
          for (int q = 0; q < 4; ++q) { u32x2 o; o.x = cvt_pk_bf16(a[q][0] * r * g[q][0], a[q][1] * r * g[q][1]); o.y = cvt_pk_bf16(a[q][2] * r * g[q][2], a[q][3] * r * g[q][3]);
              *(u32x2*)(H + (size_t)row * D + 4 * F.lane + 256 * q) = o; }
      } }
}

struct ProbProj {
    static constexpr int K = 1024; static constexpr bool PERM = true, GATHER = false, AFTER_DRAIN = false, FP8 = false;
    const bf16_t* A; const bf16_t* Bt; pg8::StaticOrder so; bf16_t *Pp, *Qp, *Rp, *Vp; int ilo, ihi;
    __device__ __forceinline__ bool next(int i, pg8::Unit& u) const { int pm, pn; if (ilo + i >= ihi || !so.next(ilo + i, pm, pn)) return false; u.m0 = pm; u.n0 = pn; u.e = 0; u.cnt = 0; u.lb = 0;
        u.a = (const char*)A + (size_t)pm * 256 * K * 2; u.b = (const char*)Bt + (size_t)pn * 256 * K * 2; return true; }
    __device__ __forceinline__ unsigned row_off(const pg8::Unit&, int) const { return 0u; }
    template <int TY> __device__ __forceinline__ void epi_t(const f32x4 (&acc)[2][2][4][2], const pg8::Unit& u, int wr, int wc, int fr, int fq) const {
        const int row0 = u.m0 * 256 + wr * 64 + fr, cl = wc * 32 + 8 * fq;
        bf16_t* dst = Pp + (size_t)TY * ((32 * MiB) / 2) + (u.n0 & 7) * 128 + cl;
#pragma unroll
        for (int ai = 0; ai < 2; ++ai)
#pragma unroll
            for (int m = 0; m < 4; ++m) {
                f32x2 o[4];
#pragma unroll
                for (int n = 0; n < 2; ++n)
#pragma unroll
                    for (int q = 0; q < 2; ++q) { const f32x2 X = (f32x2){acc[ai][0][m][n][2 * q], acc[ai][0][m][n][2 * q + 1]}, Y = (f32x2){acc[ai][1][m][n][2 * q], acc[ai][1][m][n][2 * q + 1]};
                        o[n * 2 + q] = (TY == 0) ? gelu_sig_pk(X, Y) : ((TY == 1) ? mul_sig_pk(X, Y) : X * Y); }
                u32x4 w; w.x = cvt_pk_bf16(o[0].x, o[0].y); w.y = cvt_pk_bf16(o[1].x, o[1].y); w.z = cvt_pk_bf16(o[2].x, o[2].y); w.w = cvt_pk_bf16(o[3].x, o[3].y);
                *(u32x4*)(dst + (size_t)(row0 + ai * 128 + m * 16) * D) = w; }
    }
    __device__ __forceinline__ void epi(const f32x4 (&acc)[2][2][4][2], const pg8::Unit& u, int wr, int wc, int fr, int fq) const {
        const int pn = u.n0, row0 = u.m0 * 256 + wr * 64 + fr, cl = wc * 32 + 8 * fq;
        if (pn < 8) epi_t<0>(acc, u, wr, wc, fr, fq);
        else if (pn < 16) epi_t<1>(acc, u, wr, wc, fr, fq);
        else if (pn < 24) epi_t<2>(acc, u, wr, wc, fr, fq);
        else {
            bf16_t* dst = Vp + (pn - 24) * 256 + cl;
#pragma unroll
            for (int ai = 0; ai < 2; ++ai)
#pragma unroll
                for (int m = 0; m < 4; ++m)
#pragma unroll
                    for (int bj = 0; bj < 2; ++bj) {
                        f32x2 o[4];
#pragma unroll
                        for (int n = 0; n < 2; ++n)
#pragma unroll
                            for (int q = 0; q < 2; ++q) o[n * 2 + q] = gelu_pk2((f32x2){acc[ai][bj][m][n][2 * q], acc[ai][bj][m][n][2 * q + 1]});
                        u32x4 w; w.x = cvt_pk_bf16(o[0].x, o[0].y); w.y = cvt_pk_bf16(o[1].x, o[1].y); w.z = cvt_pk_bf16(o[2].x, o[2].y); w.w = cvt_pk_bf16(o[3].x, o[3].y);
                        *(u32x4*)(dst + (size_t)(row0 + ai * 128 + m * 16) * D + bj * 128) = w; }
        }
    }
};

__device__ __forceinline__ void phase_sgu(const Frame& F) {
    const bf16_t* Pp = (const bf16_t*)(F.ws + WS_P); const bf16_t* Qp = (const bf16_t*)(F.ws + WS_Q); const bf16_t* Rp = (const bf16_t*)(F.ws + WS_R); const bf16_t* Vp = (const bf16_t*)(F.ws + WS_V);
    const bf16_t* Wsb = (const bf16_t*)(F.ws + WS_WSB); bf16_t* Mg = (bf16_t*)(F.ws + WS_H);
    LAS unsigned char* VT = F.lds;
    LAS float* ZB = (LAS float*)(F.lds + 32768);
    const int ch = F.tid & 15, pr = F.tid >> 4;
    const unsigned vbase = (unsigned)(size_t)VT;
    u32x4 vnx[4];
    if (F.bid < 1024) { const int t0 = (F.bid >> 3) * 128, c0 = (F.bid & 7) * 128;
#pragma unroll
        for (int ps = 0; ps < 4; ++ps) vnx[ps] = *(const u32x4*)(Vp + (size_t)(t0 + pr + 32 * ps) * D + c0 + 8 * ch); }
    for (int unit = F.bid; unit < 1024; unit += F.G) {
        const int chunk = unit >> 3, g = unit & 7, t0 = chunk * 128, c0 = g * 128;
        u32x4 pvv[4], qvv[4], r0v[4], rmv[4], rpv[4];
#pragma unroll
        for (int ps = 0; ps < 4; ++ps) { const int t = t0 + pr + 32 * ps; const size_t o = (size_t)t * D + c0 + 8 * ch; const int ts = t & (SEQ - 1);
            pvv[ps] = *(const u32x4*)(Pp + o); qvv[ps] = *(const u32x4*)(Qp + o); r0v[ps] = *(const u32x4*)(Rp + o);
            rmv[ps] = (u32x4){0u, 0u, 0u, 0u}; rpv[ps] = (u32x4){0u, 0u, 0u, 0u};
            if (ts > 0) rmv[ps] = *(const u32x4*)(Rp + o - D);
            if (ts < SEQ - 1) rpv[ps] = *(const u32x4*)(Rp + o + D); }
        float gs[8];
#pragma unroll
        for (int q = 0; q < 2; ++q) { const f32x4 t4 = *(const f32x4*)(F.g_sgu + c0 + 8 * ch + 4 * q); gs[4 * q] = t4[0]; gs[4 * q + 1] = t4[1]; gs[4 * q + 2] = t4[2]; gs[4 * q + 3] = t4[3]; }
#pragma unroll
        for (int ps = 0; ps < 4; ++ps) {
            const int p = pr + 32 * ps;
            const u32x4 raw = vnx[ps];
            float v[8]; v[0] = bf_lo(raw.x); v[1] = bf_hi(raw.x); v[2] = bf_lo(raw.y); v[3] = bf_hi(raw.y); v[4] = bf_lo(raw.z); v[5] = bf_hi(raw.z); v[6] = bf_lo(raw.w); v[7] = bf_hi(raw.w);
            float s = ((v[0] + v[1]) + (v[2] + v[3])) + ((v[4] + v[5]) + (v[6] + v[7]));
            s += __shfl_xor(s, 1); s += __shfl_xor(s, 2); s += __shfl_xor(s, 4); s += __shfl_xor(s, 8);
            const float mean = s * (1.0f / 128.f); float qv = 0.f;
#pragma unroll
            for (int i = 0; i < 8; ++i) { v[i] -= mean; qv += v[i] * v[i]; }
            qv += __shfl_xor(qv, 1); qv += __shfl_xor(qv, 2); qv += __shfl_xor(qv, 4); qv += __shfl_xor(qv, 8);
            const float r = 1.0f / sqrtf(qv * (1.0f / 128.f) + EPS);
            u32x4 o; o.x = cvt_pk_bf16(v[0] * r * gs[0], v[1] * r * gs[1]); o.y = cvt_pk_bf16(v[2] * r * gs[2], v[3] * r * gs[3]);
            o.z = cvt_pk_bf16(v[4] * r * gs[4], v[5] * r * gs[5]); o.w = cvt_pk_bf16(v[6] * r * gs[6], v[7] * r * gs[7]);
            *(LAS u32x4*)(VT + off_b(p, ch)) = o;
        }
        __syncthreads();
        if (unit + F.G < 1024) { const int un = unit + F.G, tn = (un >> 3) * 128, cn = (un & 7) * 128;
#pragma unroll
            for (int ps = 0; ps < 4; ++ps) vnx[ps] = *(const u32x4*)(Vp + (size_t)(tn + pr + 32 * ps) * D + cn + 8 * ch); }
        {
            const int q0 = 16 * F.wave; const int l15 = F.lane & 15, lq = F.lane >> 4;
            bf16x8 Yf[4];
#pragma unroll
            for (int ks = 0; ks < 4; ++ks) Yf[ks] = *(const bf16x8*)(Wsb + (size_t)(g * 128 + q0 + l15) * 128 + 32 * ks + 8 * lq);
            const float bq = F.b_s[g * 128 + q0 + l15];
#define SG_ISSUE(ct, S) do { const unsigned a0_ = vbase + tr_read_addr_16(F.lane, (ct), 0, 0), a1_ = vbase + tr_read_addr_16(F.lane, (ct), 0, 1); \
            asm volatile("ds_read_b64_tr_b16 %0, %8\n\tds_read_b64_tr_b16 %1, %9\n\tds_read_b64_tr_b16 %2, %8 offset:8192\n\tds_read_b64_tr_b16 %3, %9 offset:8192\n\t" \
                         "ds_read_b64_tr_b16 %4, %8 offset:16384\n\tds_read_b64_tr_b16 %5, %9 offset:16384\n\tds_read_b64_tr_b16 %6, %8 offset:24576\n\tds_read_b64_tr_b16 %7, %9 offset:24576" \
                         : "=&v"(S[0]), "=&v"(S[1]), "=&v"(S[2]), "=&v"(S[3]), "=&v"(S[4]), "=&v"(S[5]), "=&v"(S[6]), "=&v"(S[7]) : "v"(a0_), "v"(a1_) : "memory"); } while (0)
#define SG_USE(ct, S, NWAIT) do { asm volatile("s_waitcnt lgkmcnt(" #NWAIT ")" ::: "memory"); \
            asm volatile("" : "+v"(S[0]), "+v"(S[1]), "+v"(S[2]), "+v"(S[3]), "+v"(S[4]), "+v"(S[5]), "+v"(S[6]), "+v"(S[7])); \
            f32x4 acc_ = (f32x4){0.f, 0.f, 0.f, 0.f}; \
            _Pragma("unroll") for (int ks = 0; ks < 4; ++ks) { const u16x4 lo_ = S[2 * ks], hi_ = S[2 * ks + 1]; \
                const bf16x8 X_ = (bf16x8){(short)lo_[0], (short)lo_[1], (short)lo_[2], (short)lo_[3], (short)hi_[0], (short)hi_[1], (short)hi_[2], (short)hi_[3]}; \
                acc_ = __builtin_amdgcn_mfma_f32_16x16x32_bf16(X_, Yf[ks], acc_, 0, 0, 0); } \
            acc_ = acc_ + bq; *(LAS f32x4*)(ZB + (q0 + l15) * 132 + 16 * (ct) + 4 * lq) = acc_; } while (0)
            u16x4 SA[8], SB[8];
            SG_ISSUE(0, SA);
            SG_ISSUE(1, SB); SG_USE(0, SA, 8);
            SG_ISSUE(2, SA); SG_USE(1, SB, 8);
            SG_ISSUE(3, SB); SG_USE(2, SA, 8);
            SG_ISSUE(4, SA); SG_USE(3, SB, 8);
            SG_ISSUE(5, SB); SG_USE(4, SA, 8);
            SG_ISSUE(6, SA); SG_USE(5, SB, 8);
            SG_ISSUE(7, SB); SG_USE(6, SA, 8);
            SG_USE(7, SB, 0);
#undef SG_ISSUE
#undef SG_USE
        }
        __syncthreads();
        {
            float w0[8], w1[8], w2[8];
#pragma unroll
            for (int q = 0; q < 2; ++q) { const f32x4 a = *(const f32x4*)(F.w_conv + c0 + 8 * ch + 4 * q), b = *(const f32x4*)(F.w_conv + 1024 + c0 + 8 * ch + 4 * q), c = *(const f32x4*)(F.w_conv + 2048 + c0 + 8 * ch + 4 * q);
#pragma unroll
                for (int i = 0; i < 4; ++i) { w0[4 * q + i] = a[i]; w1[4 * q + i] = b[i]; w2[4 * q + i] = c[i]; } }
#pragma unroll
            for (int ps = 0; ps < 4; ++ps) {
                const int q = pr + 32 * ps, t = t0 + q; const size_t o = (size_t)t * D + c0 + 8 * ch;
                const u32x4 pv = pvv[ps], qv = qvv[ps], r0 = r0v[ps], rm = rmv[ps], rp = rpv[ps];
                const f32x4 z0 = *(const LAS f32x4*)(ZB + q * 132 + 8 * ch), z1 = *(const LAS f32x4*)(ZB + q * 132 + 8 * ch + 4);
                float zz[8] = {z0[0], z0[1], z0[2], z0[3], z1[0], z1[1], z1[2], z1[3]};
                float res[8];
#pragma unroll
                for (int i = 0; i < 4; ++i) {
                    const unsigned pw = pv[i], qw = qv[i], rmw = rm[i], r0w = r0[i], rpw = rp[i];
                    res[2 * i] = bf_lo(pw) * zz[2 * i] + bf_lo(qw) * (w0[2 * i] * bf_lo(rmw) + w1[2 * i] * bf_lo(r0w) + w2[2 * i] * bf_lo(rpw));
                    res[2 * i + 1] = bf_hi(pw) * zz[2 * i + 1] + bf_hi(qw) * (w0[2 * i + 1] * bf_hi(rmw) + w1[2 * i + 1] * bf_hi(r0w) + w2[2 * i + 1] * bf_hi(rpw));
                }
                u32x4 w; w.x = cvt_pk_bf16(res[0], res[1]); w.y = cvt_pk_bf16(res[2], res[3]); w.z = cvt_pk_bf16(res[4], res[5]); w.w = cvt_pk_bf16(res[6], res[7]);
                *(u32x4*)(Mg + o) = w;
            }
        }
        __syncthreads();
    }
}

struct ProbOut {
    static constexpr int K = 1024; static constexpr bool PERM = true, GATHER = false, AFTER_DRAIN = true, FP8 = false;
    const bf16_t* A; const bf16_t* Bt; pg8::StaticOrder so; const float* x; bf16_t* H2; unsigned char* X8; const bf16_t* WRh; float* PLG;
    __device__ __forceinline__ bool next(int i, pg8::Unit& u) const { int pm, pn; if (i > 0 || !so.next(i, pm, pn)) return false; u.m0 = pm; u.n0 = pn; u.e = 0; u.cnt = 0; u.lb = 0;
        u.a = (const char*)A + (size_t)pm * 256 * K * 2; u.b = (const char*)Bt + (size_t)pn * 256 * K * 2; return true; }
    __device__ __forceinline__ unsigned row_off(const pg8::Unit&, int) const { return 0u; }
    __device__ __forceinline__ void epi(const f32x4 (&)[2][2][4][2], const pg8::Unit&, int, int, int, int) const {}
    __device__ __forceinline__ void epi_drain(f32x4 (&acc)[2][2][4][2], const pg8::Unit& u, int wr, int wc, int fr, int fq, LAS unsigned char* lds) const {
        const int tid = (wr * 4 + wc) * 64 + fq * 16 + fr;
        const int row0 = u.m0 * 256 + wr * 64 + fr, col0 = u.n0 * 256 + wc * 32 + 8 * fq;
        LAS float* PB = (LAS float*)lds;
        LAS float* SSP = (LAS float*)(lds + TAB_OFF);
#pragma unroll
        for (int ai = 0; ai < 2; ++ai)
#pragma unroll
            for (int m = 0; m < 4; ++m) {
                float ss = 0.f;
#pragma unroll
                for (int bj = 0; bj < 2; ++bj) {
                    const size_t o = (size_t)(row0 + ai * 128 + m * 16) * D + col0 + bj * 128;
                    const f32x4 v0 = acc[ai][bj][m][0] + *(const f32x4*)(x + o), v1 = acc[ai][bj][m][1] + *(const f32x4*)(x + o + 4);
                    ss += (v0[0] * v0[0] + v0[1] * v0[1]) + (v0[2] * v0[2] + v0[3] * v0[3]) + (v1[0] * v1[0] + v1[1] * v1[1]) + (v1[2] * v1[2] + v1[3] * v1[3]);
                    u32x4 h; h.x = cvt_pk_bf16(v0[0], v0[1]); h.y = cvt_pk_bf16(v0[2], v0[3]); h.z = cvt_pk_bf16(v1[0], v1[1]); h.w = cvt_pk_bf16(v1[2], v1[3]);
                    *(u32x4*)(H2 + o) = h;
                    { u32x2 e8; e8.x = pk4_fp8(v0[0], v0[1], v0[2], v0[3]); e8.y = pk4_fp8(v1[0], v1[1], v1[2], v1[3]); *(u32x2*)(X8 + o) = e8; }
                    u32x4 l; l.x = cvt_pk_bf16(v0[0] - bf_lo(h.x), v0[1] - bf_hi(h.x)); l.y = cvt_pk_bf16(v0[2] - bf_lo(h.y), v0[3] - bf_hi(h.y));
                    l.z = cvt_pk_bf16(v1[0] - bf_lo(h.z), v1[1] - bf_hi(h.z)); l.w = cvt_pk_bf16(v1[2] - bf_lo(h.w), v1[3] - bf_hi(h.w));
                    acc[ai][bj][m][0] = __builtin_bit_cast(f32x4, h); acc[ai][bj][m][1] = __builtin_bit_cast(f32x4, l);
                }
                ss += __shfl_xor(ss, 16); ss += __shfl_xor(ss, 32);
                if (fq == 0) SSP[wc * 256 + ai * 128 + wr * 64 + m * 16 + fr] = ss;
            }
        const int rrow = tid >> 1, rhalf = tid & 1;
        float* prow = PLG + ((size_t)(u.m0 * 256 + rrow) * 4 + u.n0) * PLW;
#pragma unroll 1
        for (int jt = 0; jt < 5; ++jt) {
            bf16x8 Wf[2][2];
#pragma unroll
            for (int bj = 0; bj < 2; ++bj) { const bf16_t* wp = WRh + (size_t)(16 * jt + fr) * 1024 + u.n0 * 256 + bj * 128 + wc * 32 + 8 * fq;
                Wf[bj][0] = *(const bf16x8*)wp; Wf[bj][1] = *(const bf16x8*)(wp + 80 * 1024); }
            LAS float* pb = PB + (jt & 1) * (4 * 256 * 16) + wc * (256 * 16);
#pragma unroll
            for (int ai = 0; ai < 2; ++ai)
#pragma unroll
                for (int m = 0; m < 4; ++m) {
                    f32x4 d = (f32x4){0.f, 0.f, 0.f, 0.f};
#pragma unroll
                    for (int bj = 0; bj < 2; ++bj) { const bf16x8 xh = __builtin_bit_cast(bf16x8, acc[ai][bj][m][0]), xl = __builtin_bit_cast(bf16x8, acc[ai][bj][m][1]);
                        d = __builtin_amdgcn_mfma_f32_16x16x32_bf16(Wf[bj][0], xh, d, 0, 0, 0);
                        d = __builtin_amdgcn_mfma_f32_16x16x32_bf16(Wf[bj][0], xl, d, 0, 0, 0);
                        d = __builtin_amdgcn_mfma_f32_16x16x32_bf16(Wf[bj][1], xh, d, 0, 0, 0); }
                    *(LAS f32x4*)(pb + (ai * 128 + wr * 64 + m * 16 + fr) * 16 + 4 * fq) = d;
                }
            __syncthreads();
            { const LAS float* q = PB + (jt & 1) * (4 * 256 * 16) + rrow * 16 + 8 * rhalf;
              f32x4 s0 = *(const LAS f32x4*)q, s1 = *(const LAS f32x4*)(q + 4);
#pragma unroll
              for (int w = 1; w < 4; ++w) { s0 = s0 + *(const LAS f32x4*)(q + w * 256 * 16); s1 = s1 + *(const LAS f32x4*)(q + w * 256 * 16 + 4); }
              *(f32x4*)(prow + 16 * jt + 8 * rhalf) = s0; *(f32x4*)(prow + 16 * jt + 8 * rhalf + 4) = s1;
              if (jt == 0 && rhalf == 0) prow[80] = (SSP[rrow] + SSP[256 + rrow]) + (SSP[512 + rrow] + SSP[768 + rrow]); }
        }
    }
};

__device__ __forceinline__ void phase_router(const Frame& F) {
    const float* PLG = (const float*)(F.ws + WS_PLG);
    int* ltok = (int*)(F.ws + WS_LTOK); float* lw = (float*)(F.ws + WS_LW); float* lrs = (float*)(F.ws + WS_LRS); float* route = (float*)(F.ws + WS_ROUTE);
    unsigned* gcnt = F.ctl + CW_GCNT;
    LAS float* LG = (LAS float*)F.lds;
    LAS int* hist = (LAS int*)(F.lds + 64 * PLW * 4);
    LAS int* base = hist + 64;
    bool first = true;
    for (int unit = F.bid; unit < T / 64; unit += F.G) {
        for (int e = F.tid; e < 64 * PLW; e += NTHR) { const int tt = e / PLW, c = e - tt * PLW; const float* p = PLG + ((size_t)(unit * 64 + tt) * 4) * PLW + c;
            LG[e] = (p[0] + p[PLW]) + (p[2 * PLW] + p[3 * PLW]); }
        if (F.tid < 64) hist[F.tid] = 0;
        __syncthreads();
        if (F.wave == 0) {
            const int ln = F.lane;
            const LAS float* l0 = LG + ln * PLW;
            const float rstd = 1.0f / sqrtf(l0[80] * (1.0f / D) + EPS);
            int gi = 0; float gm = l0[64] * rstd;
#pragma unroll
            for (int j = 1; j < 8; ++j) { const float v = l0[64 + j] * rstd; if (v > gm) { gm = v; gi = j; } }
            float den = 0.f;
#pragma unroll
            for (int j = 0; j < 8; ++j) den += __expf(l0[64 + j] * rstd - gm);
            const float pg = 1.0f / den;
            const LAS float* ep = l0 + gi * 8;
            int i1 = 0; float m1 = ep[0] * rstd;
#pragma unroll
            for (int j = 1; j < 8; ++j) { const float v = ep[j] * rstd; if (v > m1) { m1 = v; i1 = j; } }
            int i2 = -1; float m2 = 0.f;
#pragma unroll
            for (int j = 0; j < 8; ++j) { const float v = ep[j] * rstd; if (j != i1 && (i2 < 0 || v > m2)) { m2 = v; i2 = j; } }
            const float ex = __expf(m2 - m1);
            const int e0 = gi * 8 + i1, e1 = gi * 8 + i2; const float w0 = pg / (1.0f + ex), w1 = pg * ex / (1.0f + ex);
            const int lp0 = __hip_atomic_fetch_add(hist + e0, 1, __ATOMIC_RELAXED, __HIP_MEMORY_SCOPE_WORKGROUP);
            const int lp1 = __hip_atomic_fetch_add(hist + e1, 1, __ATOMIC_RELAXED, __HIP_MEMORY_SCOPE_WORKGROUP);
            asm volatile("s_waitcnt lgkmcnt(0)" ::: "memory");
            { const int hc = hist[ln]; base[ln] = hc ? (int)__hip_atomic_fetch_add(gcnt + ln, (unsigned)hc, RLX_AGENT) : 0; }
            asm volatile("s_waitcnt vmcnt(0) lgkmcnt(0)" ::: "memory");
            const int t = unit * 64 + ln;
            const int p0 = base[e0] + lp0, p1 = base[e1] + lp1;
            ltok[e0 * LCAP + p0] = 2 * t; lw[e0 * LCAP + p0] = w0; lrs[e0 * LCAP + p0] = rstd;
            ltok[e1 * LCAP + p1] = 2 * t + 1; lw[e1 * LCAP + p1] = w1; lrs[e1 * LCAP + p1] = rstd;
            *(f32x4*)(route + (size_t)t * 4) = (f32x4){(float)e0, (float)e1, w0, w1};
            ((int*)(F.ws + WS_ROUTE2))[2 * t] = p0; ((int*)(F.ws + WS_ROUTE2))[2 * t + 1] = p1;
        } else if (first && F.wave >= 2) {
            convert_experts_wave<false>(F, NI_GU + F.bid * P4_ITEMS, NI_GU + (F.bid + 1) * P4_ITEMS, F.wave - 2, NWAVES - 2);
        }
        first = false;
        __syncthreads();
    }
}

__device__ __forceinline__ void moe_tables(const Frame& F) {
    LAS int* ps = (LAS int*)(F.lds + PS_OFF); LAS int* cn = (LAS int*)(F.lds + CN_OFF);
    if (F.tid < 64) {
        const int c = (int)__hip_atomic_load(F.ctl + CW_GCNT + F.tid, RLX_AGENT); cn[F.tid] = c;
        int nb = (c + 255) >> 8, incl = nb;
#pragma unroll
        for (int o = 1; o < 64; o <<= 1) { const int v = __shfl_up(incl, o); if (F.lane >= o) incl += v; }
        ps[F.tid] = incl - nb; if (F.tid == 63) ps[64] = incl;
        int ci = c;
#pragma unroll
        for (int o = 1; o < 64; o <<= 1) { const int v = __shfl_up(ci, o); if (F.lane >= o) ci += v; }
        ((LAS int*)(F.lds + CS_OFF))[F.tid] = ci - c;
    }
    __syncthreads();
}
struct MoeOrder {
    LAS const int* ps; LAS const int* cn; int nunits, G, c;
    __device__ __forceinline__ bool locate(int i, int& blk, int& j, int& e, int& bin) const {
        const int L = i * G + c; if (L >= nunits) return false;
        const int id = pg8::xcd_remap(L, nunits); blk = id >> 2; j = id & 3;
        const int lane = lane_id_fresh();
        const unsigned long long m = __ballot(ps[lane] <= blk);
        e = __builtin_amdgcn_readfirstlane(__builtin_popcountll(m) - 1); bin = blk - __builtin_amdgcn_readfirstlane(ps[e]); return true;
    }
};
struct ProbGU {
    static constexpr int K = 512; static constexpr bool PERM = true, GATHER = true, AFTER_DRAIN = false, FP8 = true;
    const unsigned char* H2; const unsigned char* Bt; unsigned char* HID; LAS const int* tab; MoeOrder mo;
    __device__ __forceinline__ bool next(int i, pg8::Unit& u) const { int blk, j, e, bin; if (!mo.locate(i, blk, j, e, bin)) return false;
        u.m0 = blk; u.n0 = j; u.e = i; u.cnt = __builtin_amdgcn_readfirstlane(mo.cn[e]) - bin * 256; u.lb = e * LCAP + bin * 256;
        u.a = (const char*)H2; u.b = (const char*)Bt + ((size_t)e * 1024 + j * 256) * K * 2; return true; }
    __device__ __forceinline__ unsigned row_off(const pg8::Unit& u, int r) const { return (unsigned)tab[u.e * 256 + r] * (unsigned)(K * 2); }
    __device__ __forceinline__ void epi(const f32x4 (&acc)[2][2][4][2], const pg8::Unit& u, int wr, int wc, int fr, int fq) const {
        const int hc = u.n0 * 128 + wc * 32 + 8 * fq;
#pragma unroll
        for (int ai = 0; ai < 2; ++ai)
#pragma unroll
            for (int m = 0; m < 4; ++m) {
                const int rl = ai * 128 + wr * 64 + m * 16 + fr;
                const float rs = ((LAS const float*)tab)[1024 + u.e * 256 + rl] * WSCALE_INV;
                f32x2 o[4];
#pragma unroll
                for (int n = 0; n < 2; ++n)
#pragma unroll
                    for (int q = 0; q < 2; ++q) { const f32x2 gt = (f32x2){acc[ai][0][m][n][2 * q], acc[ai][0][m][n][2 * q + 1]} * rs, up = (f32x2){acc[ai][1][m][n][2 * q], acc[ai][1][m][n][2 * q + 1]} * rs;
                        o[n * 2 + q] = mul_sig_pk(gt * up, gt); }
                u32x2 w; w.x = pk4_fp8(o[0].x, o[0].y, o[1].x, o[1].y); w.y = pk4_fp8(o[2].x, o[2].y, o[3].x, o[3].y);
                *(u32x2*)(HID + (size_t)(u.m0 * 256 + rl) * DE + hc) = w;
            }
    }
};
struct ProbDown {
    static constexpr int K = 256; static constexpr bool PERM = true, GATHER = false, AFTER_DRAIN = false, FP8 = true;
    const unsigned char* HID; const unsigned char* Bt; unsigned char* Y; LAS const int* cs; MoeOrder mo;
    __device__ __forceinline__ bool next(int i, pg8::Unit& u) const { int blk, j, e, bin; if (!mo.locate(i, blk, j, e, bin)) return false;
        u.m0 = blk; u.n0 = j; u.e = e; u.cnt = __builtin_amdgcn_readfirstlane(mo.cn[e]) - bin * 256; u.lb = __builtin_amdgcn_readfirstlane(cs[e]) + bin * 256;
        u.a = (const char*)HID + (size_t)blk * 256 * K * 2; u.b = (const char*)Bt + ((size_t)e * 1024 + j * 256) * K * 2; return true; }
    __device__ __forceinline__ unsigned row_off(const pg8::Unit&, int) const { return 0u; }
    __device__ __forceinline__ void epi(const f32x4 (&acc)[2][2][4][2], const pg8::Unit& u, int wr, int wc, int fr, int fq) const {
        const int col0 = u.n0 * 256 + wc * 32 + 8 * fq;
#pragma unroll
        for (int ai = 0; ai < 2; ++ai)
#pragma unroll
            for (int m = 0; m < 4; ++m) {
                const int rl = ai * 128 + wr * 64 + m * 16 + fr;
                if (rl < u.cnt) {
#pragma unroll
                    for (int bj = 0; bj < 2; ++bj) {
                        const f32x4 a = acc[ai][bj][m][0] * WSCALE_INV, b = acc[ai][bj][m][1] * WSCALE_INV;
                        u32x2 o; o.x = pk4_fp8(a[0], a[1], a[2], a[3]); o.y = pk4_fp8(b[0], b[1], b[2], b[3]);
                        *(u32x2*)(Y + (size_t)(u.lb + rl) * D + col0 + bj * 128) = o; }
                }
            }
    }
};
__device__ __forceinline__ void phase_moe_gu(const Frame& F) {
    moe_tables(F);
    LAS const int* ps = (LAS const int*)(F.lds + PS_OFF); LAS const int* cn = (LAS const int*)(F.lds + CN_OFF); LAS int* tab = (LAS int*)(F.lds + TAB_OFF);
    const int* ltok = (const int*)(F.ws + WS_LTOK);
    const float* lrs = (const float*)(F.ws + WS_LRS);
    ProbGU P; P.H2 = F.ws + WS_X8; P.Bt = F.ws + WS_BTGU; P.HID = F.ws + WS_HID; P.tab = tab;
    P.mo.ps = ps; P.mo.cn = cn; P.mo.nunits = ps[64] * 4; P.mo.G = F.G; P.mo.c = F.bid;
    for (int i = 0; i < MAXU; ++i) { int blk, j, e, bin; if (!P.mo.locate(i, blk, j, e, bin)) break;
        const int cnt = cn[e] - bin * 256;
        if (F.tid < 256) { const int idx = F.tid < cnt ? F.tid : cnt - 1; tab[i * 256 + F.tid] = ltok[e * LCAP + bin * 256 + idx] >> 1; ((LAS float*)tab)[1024 + i * 256 + F.tid] = lrs[e * LCAP + bin * 256 + idx]; } }
    __syncthreads();
    pg8::gemm_phase<ProbGU>(F.lds, P, F.wave, TS_SEL(5));
    Frame G = F; G.lane = lane_id_fresh(); G.tid = G.wave * 64 + G.lane;
    { const int NU = P.mo.nunits, r = NU % G.G, S = (r > 0) ? G.G - r : 0;
      constexpr int SLACK_ITEMS = 40;
      const int base = NI_GU + G.G * P4_ITEMS, NR = NI_DN - G.G * P4_ITEMS;
      int nslack = S * SLACK_ITEMS; if (nslack > NR) nslack = NR;
      if (S > 0 && G.bid >= r) { const int sidx = G.bid - r; int lo = sidx * SLACK_ITEMS, hi = lo + SLACK_ITEMS; if (lo > nslack) lo = nslack; if (hi > nslack) hi = nslack;
          convert_experts_wave(G, base + lo, base + hi, G.wave, NWAVES); }
      convert_experts_wave(G, base + nslack, NI_GU + NI_DN, G.bid * NWAVES + G.wave, G.G * NWAVES); }
}
__device__ __forceinline__ void phase_moe_down(const Frame& F) {
    moe_tables(F);
    LAS const int* ps = (LAS const int*)(F.lds + PS_OFF); LAS const int* cn = (LAS const int*)(F.lds + CN_OFF);
    ProbDown P; P.HID = F.ws + WS_HID; P.Bt = F.ws + WS_BTD; P.Y = F.ws + WS_Y; P.cs = (LAS const int*)(F.lds + CS_OFF);
    P.mo.ps = ps; P.mo.cn = cn; P.mo.nunits = ps[64] * 4; P.mo.G = F.G; P.mo.c = F.bid;
    pg8::gemm_phase<ProbDown>(F.lds, P, F.wave, TS_SEL(6));
}

__device__ __forceinline__ void phase_final(const Frame& F) {
    moe_tables(F);
    LAS const int* cs = (LAS const int*)(F.lds + CS_OFF);
    const unsigned char* Y = F.ws + WS_Y; const float* route = (const float*)(F.ws + WS_ROUTE); const int* rpos = (const int*)(F.ws + WS_ROUTE2);
    f32x4 g[4];
#pragma unroll
    for (int q = 0; q < 4; ++q) g[q] = *(const f32x4*)(F.g_final + 4 * F.lane + 256 * q);
    for (int row = F.bid * NWAVES + F.wave; row < T; row += F.G * NWAVES) {
        const f32x4 rr = *(const f32x4*)(route + (size_t)row * 4); const int p0 = rpos[2 * row], p1 = rpos[2 * row + 1];
        const float w0 = rr[2], w1 = rr[3];
        const bf16_t* xr = (const bf16_t*)(F.ws + WS_H2) + (size_t)row * D + 4 * F.lane; float* orow = F.out + (size_t)row * D + 4 * F.lane;
        const unsigned char* y0 = Y + (size_t)(cs[(int)rr[0]] + p0) * D + 4 * F.lane; const unsigned char* y1 = Y + (size_t)(cs[(int)rr[1]] + p1) * D + 4 * F.lane;
        f32x4 a[4]; float s = 0.f;
#pragma unroll
        for (int q = 0; q < 4; ++q) { const u32x2 ux = *(const u32x2*)(xr + 256 * q); const unsigned u0 = *(const unsigned*)(y0 + 256 * q), u1 = *(const unsigned*)(y1 + 256 * q);
            const f32x2 y0a = __builtin_amdgcn_cvt_pk_f32_fp8(u0, false), y0b = __builtin_amdgcn_cvt_pk_f32_fp8(u0, true), y1a = __builtin_amdgcn_cvt_pk_f32_fp8(u1, false), y1b = __builtin_amdgcn_cvt_pk_f32_fp8(u1, true);
            a[q][0] = bf_lo(ux.x) + (w0 * y0a.x + w1 * y1a.x); a[q][1] = bf_hi(ux.x) + (w0 * y0a.y + w1 * y1a.y);
            a[q][2] = bf_lo(ux.y) + (w0 * y0b.x + w1 * y1b.x); a[q][3] = bf_hi(ux.y) + (w0 * y0b.y + w1 * y1b.y);
            s += (a[q][0] * a[q][0] + a[q][1] * a[q][1]) + (a[q][2] * a[q][2] + a[q][3] * a[q][3]); }
        const float r = 1.0f / sqrtf(wave_sum(s) * (1.0f / D) + EPS);
#pragma unroll
        for (int q = 0; q < 4; ++q) *(f32x4*)(orow + 256 * q) = a[q] * r * g[q];
    }
}
constexpr int NPHASES = 8;
struct Args { const float* in[15]; float* out; unsigned char* ws; int ph_lo, ph_hi; };
__global__ void __launch_bounds__(NTHR, 2) fwd_kernel(Args args) {
    extern __shared__ __attribute__((aligned(16))) unsigned char lds_raw[];
    Frame F;
    F.lds = (LAS unsigned char*)lds_raw; F.tid = threadIdx.x; F.lane = F.tid & 63; F.wave = __builtin_amdgcn_readfirstlane(F.tid >> 6); F.G = gridDim.x; F.bid = blockIdx.x;
    F.ws = args.ws; F.ctl = (unsigned*)(args.ws + WS_CTL); F.out = args.out;
#ifndef X2_IN_WS
#define X2_IN_WS 0
#endif
    F.x2 = X2_IN_WS ? (float*)(args.ws + WS_X2) : args.out;
    F.x = args.in[0]; F.g_mix = args.in[1]; F.w_in = args.in[2]; F.w_s = args.in[3]; F.b_s = args.in[4]; F.g_sgu = args.in[5]; F.w_conv = args.in[6]; F.w_out = args.in[7];
    F.g_ffn = args.in[8]; F.w_rg = args.in[9]; F.w_re = args.in[10]; F.wg = args.in[11]; F.wu = args.in[12]; F.wd = args.in[13]; F.g_final = args.in[14];
    if (F.tid < 4) ((LAS unsigned*)(F.lds + MISC_OFF))[F.tid] = 0u;
    __syncthreads();
    const int lo = args.ph_lo, hi = args.ph_hi;
    const bool multi = (hi - lo) > 1;
    XcdBarrier bar; bar.bar = F.ctl + CW_BAR; bar.x = 0; bar.st = nullptr; bar.wave = F.wave;
    if (multi) bar = xcd_barrier_post(F.ctl + CW_BAR, (volatile LAS unsigned*)(F.lds + MISC_OFF));
#define IN(k) (lo <= (k) && (k) < hi)
#ifndef PROBE_DOUBLE_BAR
#define PROBE_DOUBLE_BAR 0
#endif
#define SEAM(k) do { F.lane = lane_id_fresh(); F.tid = F.wave * 64 + F.lane;     \
        if (IN(k) && IN((k) + 1)) { xcd_barrier(bar); if (PROBE_DOUBLE_BAR) xcd_barrier(bar); } } while (0)
    if (IN(0)) { phase_prologue(F); } SEAM(0);
    if (IN(1)) {
        ProbProj P; P.A = (const bf16_t*)(F.ws + WS_H); P.Bt = (const bf16_t*)(F.ws + WS_BT1); P.so.init(T, NP, F.G, F.bid);
        P.Pp = (bf16_t*)(F.ws + WS_P); P.Qp = (bf16_t*)(F.ws + WS_Q); P.Rp = (bf16_t*)(F.ws + WS_R); P.Vp = (bf16_t*)(F.ws + WS_V);
        const int nper = (P.so.nwg + F.G - 1) / F.G; int split = 2 * (((F.bid >> 3) & 7) >> 1); if (split > nper) split = nper;
        if (split > 0) { P.ilo = 0; P.ihi = split; pg8::gemm_phase<ProbProj>(F.lds, P, F.wave, TS_SEL(1)); }
        F.lane = lane_id_fresh(); F.tid = F.wave * 64 + F.lane;
        convert_experts_wave(F, 0, NI_GU, F.bid * NWAVES + F.wave, F.G * NWAVES);
        if (split < nper) { P.ilo = split; P.ihi = nper; pg8::gemm_phase<ProbProj>(F.lds, P, F.wave, TS_SEL(1)); }
    } SEAM(1);
    if (IN(2)) { phase_sgu(F); } SEAM(2);
    if (IN(3)) { ProbOut P; P.A = (const bf16_t*)(F.ws + WS_H); P.Bt = (const bf16_t*)(F.ws + WS_BT2); P.so.init(T, D, F.G, F.bid); P.x = F.x; P.H2 = (bf16_t*)(F.ws + WS_H2); P.X8 = F.ws + WS_X8;
        P.WRh = (const bf16_t*)(F.ws + WS_WR); P.PLG = (float*)(F.ws + WS_PLG);
        pg8::gemm_phase<ProbOut>(F.lds, P, F.wave); } SEAM(3);
    if (IN(4)) { phase_router(F); } SEAM(4);
    if (IN(5)) { phase_moe_gu(F); } SEAM(5);
    if (IN(6)) { phase_moe_down(F); } SEAM(6);
    if (IN(7)) { phase_final(F); }
#undef IN
#undef SEAM
}

#if DEBUG_CHECK
#ifndef REF_B
#define REF_B 0
#endif
__global__ void cmp_rows(const void* a, int a_bf16, const float* ref, int rows, float* stat) {
    float d2 = 0.f, r2 = 0.f;
    for (size_t i = (size_t)blockIdx.x * blockDim.x + threadIdx.x; i < (size_t)rows * 1024; i += (size_t)gridDim.x * blockDim.x) {
        const float av = a_bf16 ? __uint_as_float(((unsigned)((const bf16_t*)a)[i]) << 16) : ((const float*)a)[i]; const float rv = ref[i];
        const float d = av - rv; d2 += (d == d) ? d * d : 1e30f; r2 += rv * rv; }
    d2 = wave_sum(d2); r2 = wave_sum(r2);
    if ((threadIdx.x & 63) == 0) { atomicAdd(stat, d2); atomicAdd(stat + 1, r2); }
}
__global__ void cmp_pqrv(const bf16_t* Pp, const bf16_t* Qp, const bf16_t* Rp, const bf16_t* Vp, const float* proj, float* stat) {
    float d2[4] = {0.f, 0.f, 0.f, 0.f}, r2[4] = {0.f, 0.f, 0.f, 0.f};
    for (size_t i = (size_t)blockIdx.x * blockDim.x + threadIdx.x; i < (size_t)2048 * 1024; i += (size_t)gridDim.x * blockDim.x) {
        const size_t t = i >> 10; const int c = (int)(i & 1023); const float* pr = proj + t * 7168;
        const float rf[4] = {nv::gelu_t(pr[c]) * nv::sigm(pr[5120 + c]), pr[2048 + c] * nv::sigm(pr[6144 + c]), pr[3072 + c] * pr[4096 + c], nv::gelu_t(pr[1024 + c])};
        const float av[4] = {__uint_as_float(((unsigned)Pp[i]) << 16), __uint_as_float(((unsigned)Qp[i]) << 16), __uint_as_float(((unsigned)Rp[i]) << 16), __uint_as_float(((unsigned)Vp[i]) << 16)};
#pragma unroll
        for (int k = 0; k < 4; ++k) { const float d = av[k] - rf[k]; d2[k] += (d == d) ? d * d : 1e30f; r2[k] += rf[k] * rf[k]; } }
#pragma unroll
    for (int k = 0; k < 4; ++k) { const float a = wave_sum(d2[k]), b = wave_sum(r2[k]); if ((threadIdx.x & 63) == 0) { atomicAdd(stat + 2 * k, a); atomicAdd(stat + 2 * k + 1, b); } }
}
__global__ void cmp_route(const float* mine, const float* ref, float* stat) {
    const int t = blockIdx.x * blockDim.x + threadIdx.x; if (t >= 2048) return;
    const float a0 = mine[t * 4], a1 = mine[t * 4 + 1], b0 = ref[t * 4], b1 = ref[t * 4 + 1];
    const bool same = (a0 == b0 && a1 == b1) || (a0 == b1 && a1 == b0);
    float gd = 0.f; if (same) { const float w0 = (a0 == b0) ? ref[t * 4 + 2] : ref[t * 4 + 3], w1 = (a0 == b0) ? ref[t * 4 + 3] : ref[t * 4 + 2]; gd = fabsf(mine[t * 4 + 2] - w0) + fabsf(mine[t * 4 + 3] - w1); }
    atomicAdd(stat, same ? 0.f : 1.f); atomicAdd(stat + 1, 0.03f);
    atomicAdd(stat + 2, gd); atomicAdd(stat + 3, 1.0f);
}
__global__ void verdict(float* out, const float* stat, int nstage, size_t n) {
    int bad = 0;
    for (int k = 0; k < nstage; ++k) { const float d = stat[2 * k], r = stat[2 * k + 1]; float tol = 1e-3f; if (k == 7) tol = 1.0f;
        if (!(d <= tol * r)) { bad = k + 1; break; } }
    if (!bad) return;
    for (size_t i = (size_t)blockIdx.x * blockDim.x + threadIdx.x; i < n; i += (size_t)gridDim.x * blockDim.x) out[i] = (float)bad;
}
#endif

#if TSTAT
__global__ void tstat_out(float* out, const float* stat, int sel, size_t n) {
    const float avg = fmaxf(stat[sel] / fmaxf(stat[3], 1.f), 1.f);
    float v = floorf(logf(avg / TS_SCALE) / logf(TS_RATIO)) + 1.f; v = fminf(fmaxf(v, 1.f), 9.f);
    for (size_t i = (size_t)blockIdx.x * blockDim.x + threadIdx.x; i < n; i += (size_t)gridDim.x * blockDim.x) out[i] = v;
}
#endif
extern "C" void kernel_launch(void* const* d_in, const int* in_sizes, int n_in, void* d_out, int out_size, void* d_ws, size_t ws_size, hipStream_t stream) {
    static int grid = 0;
    if (grid == 0) {
        if (n_in != 15 || in_sizes[0] != T * D || out_size != T * D || ws_size < WS_NEED) { fprintf(stderr, "kernel_launch: unexpected problem (n_in %d, in0 %d, out %d, ws %zu)\n", n_in, n_in > 0 ? in_sizes[0] : -1, out_size, ws_size); grid = -1; return; }
        int dev = 0, cus = 0, per_cu = 0;
        if (hipGetDevice(&dev) != hipSuccess || hipDeviceGetAttribute(&cus, hipDeviceAttributeMultiprocessorCount, dev) != hipSuccess) { grid = -1; return; }
        if (hipFuncSetAttribute((const void*)fwd_kernel, hipFuncAttributeMaxDynamicSharedMemorySize, LDS_BYTES) != hipSuccess) { fprintf(stderr, "kernel_launch: hipFuncSetAttribute failed\n"); grid = -1; return; }
        if (hipOccupancyMaxActiveBlocksPerMultiprocessor(&per_cu, (const void*)fwd_kernel, NTHR, LDS_BYTES) != hipSuccess || per_cu < 1) { fprintf(stderr, "kernel_launch: occupancy query says %d\n", per_cu); }
        (void)hipGetLastError();
        grid = cus;
        if (grid != 256) fprintf(stderr, "kernel_launch: note: %d CUs\n", grid);
    }
    if (grid < 0) return;
    (void)hipMemsetAsync((char*)d_ws + WS_CTL, 0, CTL_ZERO_BYTES, stream);
    Args a{};
    for (int i = 0; i < 15; ++i) a.in[i] = (const float*)d_in[i];
    a.out = (float*)d_out; a.ws = (unsigned char*)d_ws;
#if DEBUG_CHECK
    {
        char* ws = (char*)d_ws; float* stat = (float*)(ws + WS_CTL) + CW_STAT;
        nv::Bufs B; B.h = (float*)(ws + WS_DBG); B.proj = (float*)(ws + WS_DBG + 8 * MiB); B.merged = (float*)(ws + WS_DBG + 64 * MiB); B.x2 = (float*)(ws + WS_DBG + 72 * MiB);
        float* nout = (float*)(ws + WS_DBG + 80 * MiB); float* nroute = (float*)(ws + WS_DBG + 88 * MiB);
        nv::run_seq(d_in, REF_B, B, nout, nroute, stream);
        const size_t ro = (size_t)REF_B * 2048 * 1024;
        for (int p = 0; p < NPHASES; ++p) {
            a.ph_lo = p; a.ph_hi = p + 1;
            hipLaunchKernelGGL(fwd_kernel, dim3(grid), dim3(NTHR), LDS_BYTES, stream, a);
            if (p == 0) hipLaunchKernelGGL(cmp_rows, dim3(256), dim3(256), 0, stream, (const void*)((const bf16_t*)(ws + WS_H) + ro), 1, (const float*)B.h, 2048, stat + 0);
            if (p == 1) hipLaunchKernelGGL(cmp_pqrv, dim3(256), dim3(256), 0, stream, (const bf16_t*)(ws + WS_P) + ro, (const bf16_t*)(ws + WS_Q) + ro, (const bf16_t*)(ws + WS_R) + ro, (const bf16_t*)(ws + WS_V) + ro, (const float*)B.proj, stat + 2);
            if (p == 2) hipLaunchKernelGGL(cmp_rows, dim3(256), dim3(256), 0, stream, (const void*)((const bf16_t*)(ws + WS_H) + ro), 1, (const float*)B.merged, 2048, stat + 10);
            if (p == 3) hipLaunchKernelGGL(cmp_rows, dim3(256), dim3(256), 0, stream, (const void*)((const bf16_t*)(ws + WS_H2) + ro), 1, (const float*)B.x2, 2048, stat + 12);
            if (p == 4) hipLaunchKernelGGL(cmp_route, dim3(8), dim3(256), 0, stream, (const float*)(ws + WS_ROUTE) + (size_t)REF_B * 2048 * 4, (const float*)nroute, stat + 14);
            if (p == 7) hipLaunchKernelGGL(cmp_rows, dim3(256), dim3(256), 0, stream, (const void*)((const float*)d_out + ro), 0, (const float*)nout, 2048, stat + 18);
        }
        hipLaunchKernelGGL(verdict, dim3(256), dim3(256), 0, stream, (float*)d_out, (const float*)stat, 10, (size_t)T * D);
    }
#else
#ifndef N_LAUNCH_PER_PHASE
#define N_LAUNCH_PER_PHASE 1
#endif
#ifndef PROBE_REPEAT
#define PROBE_REPEAT -1
#endif
    if (N_LAUNCH_PER_PHASE) { for (int p = 0; p < NPHASES; ++p) { a.ph_lo = p; a.ph_hi = p + 1; hipLaunchKernelGGL(fwd_kernel, dim3(grid), dim3(NTHR), LDS_BYTES, stream, a);
        if (p == PROBE_REPEAT && p == 4) (void)hipMemsetAsync((char*)d_ws + WS_CTL + CW_GCNT * 4, 0, 256, stream);
        if (p == PROBE_REPEAT) hipLaunchKernelGGL(fwd_kernel, dim3(grid), dim3(NTHR), LDS_BYTES, stream, a); } }
    else { a.ph_lo = 0; a.ph_hi = NPHASES; hipLaunchKernelGGL(fwd_kernel, dim3(grid), dim3(NTHR), LDS_BYTES, stream, a); }
#if TSTAT
    hipLaunchKernelGGL(tstat_out, dim3(256), dim3(256), 0, stream, (float*)d_out, (const float*)((char*)d_ws + WS_CTL) + CW_STAT, TS_COMP, (size_t)T * D);
#endif
#endif
}
```

```cpp
#include <hip/hip_runtime.h>
#include <cstdio>
#include <cstdint>
#define DEBUG_CHECK 0
#define N_LAUNCH_PER_PHASE 0
#define GAS __attribute__((address_space(1)))
#define LAS __attribute__((address_space(3)))
typedef unsigned short bf16_t;
typedef short bf16x8 __attribute__((ext_vector_type(8)));
typedef float f32x4 __attribute__((ext_vector_type(4)));
typedef float f32x2 __attribute__((ext_vector_type(2)));
typedef unsigned u32x4 __attribute__((ext_vector_type(4)));
typedef unsigned u32x2 __attribute__((ext_vector_type(2)));
typedef unsigned short u16x4 __attribute__((ext_vector_type(4)));

constexpr int T = 16384, D = 1024, NP = 7168, NE = 64, DE = 512, SEQ = 2048, LCAP = 16384;
constexpr float EPS = 1e-6f;
constexpr int NWAVES = 8, NTHR = 512;

#define RLX_AGENT __ATOMIC_RELAXED, __HIP_MEMORY_SCOPE_AGENT
#define LDS_WAIT() asm volatile("s_waitcnt lgkmcnt(0)" ::: "memory")
#define VM_WAIT() asm volatile("s_waitcnt vmcnt(0)" ::: "memory")

__device__ __forceinline__ int lane_id_fresh() { int l; asm volatile("v_mbcnt_lo_u32_b32 %0, -1, 0\n\tv_mbcnt_hi_u32_b32 %0, -1, %0" : "=v"(l)); return l; }
__device__ __forceinline__ unsigned cvt_pk_bf16(float lo, float hi) { unsigned r; asm volatile("v_cvt_pk_bf16_f32 %0, %1, %2" : "=v"(r) : "v"(lo), "v"(hi)); return r; }
typedef int v4i_t __attribute__((ext_vector_type(4)));
typedef int v8i_t __attribute__((ext_vector_type(8)));
__device__ __forceinline__ v8i_t cat8(bf16x8 lo, bf16x8 hi) { const v4i_t a = __builtin_bit_cast(v4i_t, lo), b = __builtin_bit_cast(v4i_t, hi); return __builtin_shufflevector(a, b, 0, 1, 2, 3, 4, 5, 6, 7); }
__device__ __forceinline__ unsigned pk4_fp8(float a, float b, float c, float d) { unsigned w = 0u; w = __builtin_amdgcn_cvt_pk_fp8_f32(a, b, w, false); w = __builtin_amdgcn_cvt_pk_fp8_f32(c, d, w, true); return w; }
__device__ __forceinline__ float bf_lo(unsigned w) { return __uint_as_float(w << 16); }
__device__ __forceinline__ float bf_hi(unsigned w) { return __uint_as_float(w & 0xffff0000u); }
__device__ __forceinline__ float wave_sum(float v) {
#pragma unroll
    for (int o = 1; o < 64; o <<= 1) v += __shfl_xor(v, o);
    return v;
}
__device__ __forceinline__ float fast_sigm(float y) { return __builtin_amdgcn_rcpf(1.0f + __builtin_amdgcn_exp2f(-1.4426950408889634f * y)); }
__device__ __forceinline__ float fast_gelu(float x) { return x * fast_sigm(1.5957691216057308f * (x + 0.044715f * x * x * x)); }
#define GK1 (-2.3022081986f)
#define GK2 (-0.1029432396f)
__device__ __forceinline__ f32x2 exp2_pk(f32x2 a) { f32x2 r; r.x = __builtin_amdgcn_exp2f(a.x); r.y = __builtin_amdgcn_exp2f(a.y); return r; }
__device__ __forceinline__ f32x2 rcp_pk(f32x2 a) { f32x2 r; r.x = __builtin_amdgcn_rcpf(a.x); r.y = __builtin_amdgcn_rcpf(a.y); return r; }
__device__ __forceinline__ f32x2 gelu_sig_pk(f32x2 x, f32x2 y) {
    const f32x2 t = x * x, p = t * GK2 + GK1, ea = exp2_pk(x * p), ey = exp2_pk(y * (-1.4426950408889634f));
    return x * rcp_pk((ea + 1.0f) * (ey + 1.0f));
}
__device__ __forceinline__ f32x2 mul_sig_pk(f32x2 x, f32x2 y) { return x * rcp_pk(exp2_pk(y * (-1.4426950408889634f)) + 1.0f); }
__device__ __forceinline__ f32x2 gelu_pk2(f32x2 x) { const f32x2 t = x * x, p = t * GK2 + GK1; return x * rcp_pk(exp2_pk(x * p) + 1.0f); }

#define XB_TMO      128
#define XB_XCNT(j)  (256  + 64 * (j))
#define XB_XSUB(j)  (1280 + 64 * (j))
#define XB_XGEN(j)  (2304 + 64 * (j))
#define XB_TOP      3328
#define XB_TOPGEN   3392
#define XCD_BAR_WORDS 3456
#define XB_SPIN_CAP (1u << 18)
__device__ __forceinline__ unsigned xb_ld(unsigned* p)              { return __hip_atomic_load(p, __ATOMIC_RELAXED, __HIP_MEMORY_SCOPE_AGENT); }
__device__ __forceinline__ unsigned xb_add(unsigned* p, unsigned v) { return __hip_atomic_fetch_add(p, v, __ATOMIC_RELAXED, __HIP_MEMORY_SCOPE_AGENT); }
__device__ __forceinline__ unsigned xb_xcc_id() { return (unsigned)__builtin_amdgcn_s_getreg((3 << 11) | 20) & 0xFu; }
#define XB_SPIN(cond, bar) do { unsigned _sp = 0; while (cond) { __builtin_amdgcn_s_sleep(1); \
    if ((++_sp & 255u) == 0u) { if (xb_ld(&(bar)[XB_TMO])) break; if (_sp > XB_SPIN_CAP) { atomicAdd(&(bar)[XB_TMO], 1u); break; } } } } while (0)
struct XcdBarrier { unsigned* bar; unsigned x; volatile LAS unsigned* st; int wave; };
__device__ __forceinline__ XcdBarrier xcd_barrier_post(unsigned* bar, volatile LAS unsigned* st) {
    XcdBarrier b; b.bar = bar; b.x = xb_xcc_id(); b.st = st; b.wave = __builtin_amdgcn_readfirstlane((int)(threadIdx.x >> 6));
    if (threadIdx.x == 0) (void)xb_add(&bar[XB_XCNT(b.x)], 1u);
    return b;
}
__device__ __forceinline__ void xcd_barrier_complete(unsigned* bar, unsigned x, unsigned& nloc, unsigned& nx) {
    const unsigned G = gridDim.x * gridDim.y * gridDim.z;
    unsigned sum, cnt, mine, sp = 0u;
    for (;;) {
        sum = 0u; cnt = 0u; mine = 0u;
#pragma unroll
        for (unsigned j = 0; j < 16; ++j) { const unsigned c = xb_ld(&bar[XB_XCNT(j)]); sum += c; cnt += (c > 0u) ? 1u : 0u; mine = (j == x) ? c : mine; }
        if (sum == G) break;
        __builtin_amdgcn_s_sleep(1);
        if ((++sp & 255u) == 0u) { if (xb_ld(&bar[XB_TMO])) break; if (sp > XB_SPIN_CAP) { atomicAdd(&bar[XB_TMO], 1u); break; } }
    }
    nloc = mine > 0u ? mine : 1u; nx = cnt > 0u ? cnt : 1u;
}
__device__ __forceinline__ void xcd_barrier(const XcdBarrier& b) {
    asm volatile("s_waitcnt vmcnt(0)" ::: "memory");
    __syncthreads();
    if (b.wave == 0 && lane_id_fresh() == 0) {
        unsigned* bar = b.bar;
        __builtin_amdgcn_s_waitcnt(0);
        unsigned nloc = b.st[0], nx = b.st[1];
        if (nloc == 0u) { xcd_barrier_complete(bar, b.x, nloc, nx); b.st[0] = nloc; b.st[1] = nx; }
        const unsigned old = xb_add(&bar[XB_XSUB(b.x)], 1u);
        const unsigned gen = old / nloc;
        if (old + 1u == (gen + 1u) * nloc) {
            __builtin_amdgcn_fence(__ATOMIC_RELEASE, "agent");
            asm volatile("s_waitcnt vmcnt(0)" ::: "memory");
            const unsigned og = xb_add(&bar[XB_TOP], 1u);
            const unsigned tg = og / nx;
            if (og + 1u == (tg + 1u) * nx) xb_add(&bar[XB_TOPGEN], 1u);
            else XB_SPIN(xb_ld(&bar[XB_TOPGEN]) == tg, bar);
            __builtin_amdgcn_fence(__ATOMIC_ACQUIRE, "agent");
            xb_add(&bar[XB_XGEN(b.x)], 1u);
            asm volatile("s_waitcnt vmcnt(0)" ::: "memory");
        } else {
            XB_SPIN(xb_ld(&bar[XB_XGEN(b.x)]) == gen, bar);
            __builtin_amdgcn_fence(__ATOMIC_ACQUIRE, "agent");
            asm volatile("s_waitcnt vmcnt(0)" ::: "memory");
        }
    }
    __syncthreads();
}

template <bool ACQ>
__device__ __forceinline__ void group_barrier(unsigned* cnt, unsigned target, unsigned* bar, int wave) {
    asm volatile("s_waitcnt vmcnt(0)" ::: "memory");
    __syncthreads();
    if (wave == 0 && lane_id_fresh() == 0) {
        (void)xb_add(cnt, 1u);
        XB_SPIN(xb_ld(cnt) < target, bar);
        if (ACQ) { __builtin_amdgcn_fence(__ATOMIC_ACQUIRE, "agent"); asm volatile("s_waitcnt vmcnt(0)" ::: "memory"); }
        else asm volatile("" ::: "memory");
    }
    __syncthreads();
}
typedef unsigned bl4_t __attribute__((__vector_size__(16)));
typedef unsigned bl2_t __attribute__((__vector_size__(8)));
__device__ __forceinline__ __amdgpu_buffer_rsrc_t wt_rsrc(const void* base) { return __builtin_amdgcn_make_buffer_rsrc((void*)base, (short)0, 0x7fffffff, 0x00020000); }
__device__ __forceinline__ void st_wt16(__amdgpu_buffer_rsrc_t r, unsigned off, u32x4 v) { __builtin_amdgcn_raw_buffer_store_b128(__builtin_bit_cast(bl4_t, v), r, (int)off, 0, 16  ); }
__device__ __forceinline__ void st_wt8(__amdgpu_buffer_rsrc_t r, unsigned off, u32x2 v) { __builtin_amdgcn_raw_buffer_store_b64(__builtin_bit_cast(bl2_t, v), r, (int)off, 0, 16  ); }
__device__ __forceinline__ void st_wt4(__amdgpu_buffer_rsrc_t r, unsigned off, float v) { __builtin_amdgcn_raw_buffer_store_b32(__builtin_bit_cast(unsigned, v), r, (int)off, 0, 16  ); }
namespace pg8 {
constexpr int BM = 256, BK = 64, HALF = 128, HTB = HALF * BK * 2, STAGE_BYTES = 8 * HTB, NXCD = 8, WGM = 8;
__host__ __device__ __forceinline__ int lds_byte(int r, int c) { const int st = (r >> 4) * 2 + (c >> 5), rr = r & 15, cc = c & 31, ob = rr * 64 + cc * 2; return st * 1024 + (ob ^ (((ob >> 9) & 1) << 5)); }
__host__ __device__ __forceinline__ void stage_rc(int b, int& R, int& C) { const int st = b / 1024, sb = b % 1024, swz = sb ^ (((sb >> 9) & 1) << 5); R = (st >> 1) * 16 + swz / 64; C = (st & 1) * 32 + (swz % 64) / 2; }
__host__ __device__ __forceinline__ int perm32(int rho) { const int n = rho >> 4, i = rho & 15; return 8 * (i >> 2) + 4 * n + (i & 3); }
__host__ __device__ __forceinline__ int xcd_remap(int L, int nwg) { const int q = nwg / NXCD, r = nwg % NXCD, xcd = L % NXCD, off = L / NXCD; return (xcd < r ? xcd * (q + 1) : r * (q + 1) + (xcd - r) * q) + off; }

struct Unit { const char* a; const char* b; int m0, n0, e, cnt, lb; };

struct StaticOrder {
    int nM, nN, nwg, G, c;
    __host__ __device__ void init(int M, int N, int G_, int c_) { nM = M / BM; nN = N / BM; nwg = nM * nN; G = G_; c = c_; }
    __host__ __device__ bool next(int i, int& pm, int& pn) const {
        const long L = (long)i * G + c; if (L >= nwg) return false;
        const int wgid = xcd_remap((int)L, nwg);
        const int nig = WGM * nN, gid = wgid / nig, fm = gid * WGM, gsz = (nM - fm) < WGM ? (nM - fm) : WGM;
        pm = fm + ((wgid % nig) % gsz); pn = (wgid % nig) / gsz; return true;
    }
};

#ifndef TSTAT
#define TSTAT 0
#endif
template <class P>
__device__ __forceinline__ void gemm_phase(LAS unsigned char* lds, const P& S, int wid, float* tstat = nullptr) {
#if TSTAT
    unsigned long long ts_k = 0, ts_e = 0, ts_g = 0, ts_n = 0, tsA = 0, tsB = 0, tsC = 0;
#endif
    constexpr int K = P::K, nt = K / BK;
    const int lane = lane_id_fresh(), tid = wid * 64 + lane, wr = wid >> 2, wc = wid & 3, fr = lane & 15, fq = lane >> 4;
    unsigned voffB[2];
#pragma unroll
    for (int i = 0; i < 2; ++i) { int R, C; stage_rc(tid * 16 + i * 8192, R, C); const int Rb = P::PERM ? ((R & ~31) + perm32(R & 31)) : R; voffB[i] = (unsigned)(Rb * K + C) * 2u; }
    constexpr size_t kstep = (size_t)(BK * 2);
    constexpr size_t hstep = (size_t)HALF * K * 2;
    const unsigned ldsw = (unsigned)wid * 1024u;
    const int aoff = lds_byte(wr * 64 + fr, fq * 8), boff = lds_byte(wc * 32 + fr, fq * 8);
#define PG8_SA(b, h) (((b) * 2 + (h)) * HTB)
#define PG8_SB(b, h) ((4 + (b) * 2 + (h)) * HTB)
#define PG8_STAGE_B(bufoff, gbase) do { _Pragma("unroll") for (int _i = 0; _i < 2; ++_i) { unsigned o_ = voffB[_i]; asm volatile("" : "+v"(o_)); \
        __builtin_amdgcn_global_load_lds((const unsigned*)((const char*)(gbase) + o_), (LAS unsigned*)(lds + (bufoff) + ldsw + _i * 8192), 16, 0, 0); } } while (0)
#define PG8_STAGE_A(bufoff, gbase, offs, h) do { _Pragma("unroll") for (int _i = 0; _i < 2; ++_i) { unsigned o_ = (offs)[h][_i]; asm volatile("" : "+v"(o_)); \
        __builtin_amdgcn_global_load_lds((const unsigned*)((const char*)(gbase) + o_), (LAS unsigned*)(lds + (bufoff) + ldsw + _i * 8192), 16, 0, P::A_AUX); } } while (0)
#define PG8_LDA(dst, b, h) do { _Pragma("unroll") for (int m = 0; m < 4; ++m) _Pragma("unroll") for (int k = 0; k < 2; ++k) dst[m][k] = *(const LAS bf16x8*)(lds + PG8_SA(b, h) + aoff + m * 2048 + k * 1024); } while (0)
#define PG8_LDB(dst, b, h) do { _Pragma("unroll") for (int n = 0; n < 2; ++n) _Pragma("unroll") for (int k = 0; k < 2; ++k) dst[n][k] = *(const LAS bf16x8*)(lds + PG8_SB(b, h) + boff + n * 2048 + k * 1024); } while (0)
#define PG8_MMA(ai, bj, At, Bt) do { __builtin_amdgcn_s_setprio(1); _Pragma("unroll") for (int m = 0; m < 4; ++m) _Pragma("unroll") for (int n = 0; n < 2; ++n) _Pragma("unroll") for (int k = 0; k < 2; ++k) \
        acc[ai][bj][m][n] = __builtin_amdgcn_mfma_f32_16x16x32_bf16(Bt[n][k], At[m][k], acc[ai][bj][m][n], 0, 0, 0); __builtin_amdgcn_s_setprio(0); } while (0)
#define PG8_MMA8(ai, bj, At, Bt) do { __builtin_amdgcn_s_setprio(1); _Pragma("unroll") for (int m = 0; m < 4; ++m) _Pragma("unroll") for (int n = 0; n < 2; ++n) \
        acc[ai][bj][m][n] = __builtin_amdgcn_mfma_scale_f32_16x16x128_f8f6f4(cat8(Bt[n][0], Bt[n][1]), cat8(At[m][0], At[m][1]), acc[ai][bj][m][n], 0, 0, 0, 0x7f7f7f7f, 0, 0x7f7f7f7f); __builtin_amdgcn_s_setprio(0); } while (0)
#define PG8_MM(ai, bj, At, Bt) do { if constexpr (P::FP8) PG8_MMA8(ai, bj, At, Bt); else PG8_MMA(ai, bj, At, Bt); } while (0)
#define PG8_WAIT_V(n) asm volatile("s_waitcnt vmcnt(" #n ")" ::: "memory")
#define PG8_WAIT_L(n) asm volatile("s_waitcnt lgkmcnt(" #n ")" ::: "memory")
#define PG8_BAR __builtin_amdgcn_s_barrier()
#define PG8_SCHED __builtin_amdgcn_sched_barrier(0)
    Unit cur, nxt; int ui = 0;
    if (!S.next(0, cur)) return;
    f32x4 acc[2][2][4][2];
#pragma unroll
    for (int a = 0; a < 2; ++a)
#pragma unroll
        for (int b = 0; b < 2; ++b)
#pragma unroll
            for (int m = 0; m < 4; ++m)
#pragma unroll
                for (int n = 0; n < 2; ++n) acc[a][b][m][n] = (f32x4){0.f, 0.f, 0.f, 0.f};
    bf16x8 At[4][2], B0[2][2], B1[2][2];
    unsigned vAc[2][2];
#pragma unroll
    for (int h = 0; h < 2; ++h)
#pragma unroll
        for (int i = 0; i < 2; ++i) { int R, C; stage_rc(tid * 16 + i * 8192, R, C);
            if constexpr (P::GATHER) vAc[h][i] = S.row_off(cur, h * HALF + R) + (unsigned)C * 2u;
            else vAc[h][i] = (unsigned)((h * HALF + R) * K + C) * 2u;
        }
    const char* cA = cur.a; const char* cB = cur.b;
    PG8_STAGE_B(PG8_SB(0, 0), cB); PG8_STAGE_B(PG8_SB(0, 1), cB + hstep); PG8_STAGE_A(PG8_SA(0, 0), cA, vAc, 0); PG8_STAGE_A(PG8_SA(0, 1), cA, vAc, 1);
    if (wr == 1) PG8_BAR;
    PG8_WAIT_V(2); PG8_BAR;
    PG8_STAGE_B(PG8_SB(1, 0), cB + kstep); PG8_STAGE_A(PG8_SA(1, 0), cA + kstep, vAc, 0); PG8_STAGE_B(PG8_SB(1, 1), cB + hstep + kstep);
    PG8_WAIT_V(6); PG8_BAR;
    for (;;) {
#if TSTAT
        if (tstat) { tsA = __builtin_amdgcn_s_memrealtime(); if (ts_n) ts_g += tsA - tsC; }
#endif
        const bool has_next = S.next(ui + 1, nxt);
        const char* nA = has_next ? nxt.a : cA; const char* nB = has_next ? nxt.b : cB;

#pragma clang loop unroll(disable)
        for (int t = 0; t < nt; t += 2) {
            const bool last = (t == nt - 2);
            const char* a1 = cA + (size_t)(t + 1) * kstep;
            const char* a2 = last ? nA : cA + (size_t)(t + 2) * kstep; const char* b2 = last ? nB : cB + (size_t)(t + 2) * kstep;
            const char* a3 = a2 + kstep; const char* b3 = b2 + kstep;
            PG8_LDB(B0, 0, 0); PG8_LDB(B1, 0, 1); PG8_SCHED; PG8_LDA(At, 0, 0); PG8_STAGE_A(PG8_SA(1, 1), a1, vAc, 1);
            if constexpr (P::GATHER) { if (last && has_next) {
#pragma unroll
                for (int h = 0; h < 2; ++h)
#pragma unroll
                    for (int i = 0; i < 2; ++i) { int R, C; stage_rc((wid * 64 + lane_id_fresh()) * 16 + i * 8192, R, C); vAc[h][i] = S.row_off(nxt, h * HALF + R) + (unsigned)C * 2u; } } }
            PG8_WAIT_V(8); PG8_WAIT_L(0); PG8_BAR; PG8_MM(0, 0, At, B0); PG8_MM(0, 1, At, B1); PG8_BAR; PG8_SCHED;
            PG8_LDA(At, 0, 1); PG8_STAGE_B(PG8_SB(0, 0), b2); PG8_STAGE_B(PG8_SB(0, 1), b2 + hstep); PG8_STAGE_A(PG8_SA(0, 0), a2, vAc, 0);
            PG8_WAIT_V(8); PG8_WAIT_L(0); PG8_BAR; PG8_MM(1, 0, At, B0); PG8_MM(1, 1, At, B1); PG8_BAR; PG8_SCHED;
            PG8_LDB(B0, 1, 0); PG8_LDB(B1, 1, 1); PG8_SCHED; PG8_LDA(At, 1, 0); PG8_STAGE_A(PG8_SA(0, 1), a2, vAc, 1);
            PG8_WAIT_V(8); PG8_WAIT_L(0); PG8_BAR; PG8_MM(0, 0, At, B0); PG8_MM(0, 1, At, B1); PG8_BAR; PG8_SCHED;
            PG8_LDA(At, 1, 1); PG8_STAGE_B(PG8_SB(1, 0), b3); PG8_STAGE_B(PG8_SB(1, 1), b3 + hstep); PG8_STAGE_A(PG8_SA(1, 0), a3, vAc, 0);
            PG8_WAIT_V(8); PG8_WAIT_L(0); PG8_BAR; PG8_MM(1, 0, At, B0); PG8_MM(1, 1, At, B1); PG8_BAR; PG8_SCHED;
        }
#if TSTAT
        if (tstat) tsB = __builtin_amdgcn_s_memrealtime();
#endif
        if (wr == 0) PG8_BAR;
        if constexpr (!P::AFTER_DRAIN) { const int l_ = lane_id_fresh();
            S.epi(acc, cur, wr, wc, l_ & 15, l_ >> 4); }
#if TSTAT
        if (tstat) { tsC = __builtin_amdgcn_s_memrealtime(); ts_k += tsB - tsA; ts_e += tsC - tsB; ts_n += 1; }
#endif
        if (!has_next) break;
#pragma unroll
        for (int a = 0; a < 2; ++a)
#pragma unroll
            for (int b = 0; b < 2; ++b)
#pragma unroll
                for (int m = 0; m < 4; ++m)
#pragma unroll
                    for (int n = 0; n < 2; ++n) acc[a][b][m][n] = (f32x4){0.f, 0.f, 0.f, 0.f};
        cur = nxt; cA = nA; cB = nB; ++ui;
        if (wr == 1) PG8_BAR;
    }
    PG8_WAIT_V(0);
    PG8_BAR;
    if constexpr (P::AFTER_DRAIN) { const int l_ = lane_id_fresh(); S.epi_drain(acc, cur, wr, wc, l_ & 15, l_ >> 4, lds); }
#if TSTAT
    if (tstat && tid == 0) { atomicAdd(tstat + 0, (float)ts_k); atomicAdd(tstat + 1, (float)ts_e); atomicAdd(tstat + 2, (float)ts_g); atomicAdd(tstat + 3, (float)ts_n); }
#endif
#undef PG8_SA
#undef PG8_SB
#undef PG8_STAGE_A
#undef PG8_STAGE_B
#undef PG8_LDA
#undef PG8_LDB
#undef PG8_MMA
#undef PG8_MMA8
#undef PG8_MM
#undef PG8_WAIT_V
#undef PG8_WAIT_L
#undef PG8_BAR
#undef PG8_SCHED
}
}
constexpr size_t MiB = (size_t)1 << 20;
constexpr size_t WS_CTL = 0, CTL_ZERO_BYTES = 32 * 1024;
constexpr size_t WS_BT1 = 2 * MiB;
constexpr size_t WS_BT2 = 16 * MiB;
constexpr size_t WS_WR = 18 * MiB;
constexpr size_t WS_WSB = 19 * MiB;
constexpr size_t WS_BTGU = 20 * MiB;
constexpr size_t WS_BTD = 212 * MiB;
constexpr size_t WS_H = 212 * MiB;
constexpr size_t WS_C = 244 * MiB;
constexpr size_t WS_P = WS_C, WS_Q = WS_C + 32 * MiB, WS_R = WS_C + 64 * MiB, WS_V = WS_C + 96 * MiB;
constexpr size_t WS_H2 = WS_C, WS_HID = WS_C + 32 * MiB, WS_Y = WS_C + 96 * MiB;
constexpr size_t WS_X8 = WS_C + 64 * MiB;
constexpr size_t WS_PLG = WS_Y;
constexpr int PLW = 84;
constexpr size_t WS_LTOK = 404 * MiB, WS_LW = 408 * MiB, WS_LRS = 412 * MiB;
constexpr size_t WS_X2 = 420 * MiB;
constexpr size_t WS_ROUTE = 416 * MiB;
constexpr size_t WS_ROUTE2 = WS_ROUTE + 512 * 1024;
constexpr size_t WS_DBG = 417 * MiB;
constexpr size_t WS_NEED = 512 * MiB;
constexpr int CW_TMO = 0, CW_GBAR = 384, CW_XMAP = 640, CW_GCNT = 1024, CW_STAT = 2048, CW_BAR = 4096;
static_assert((CW_BAR + XCD_BAR_WORDS) * 4 <= (int)CTL_ZERO_BYTES, "ctl");
#if TSTAT
#define TS_SEL(k) ((k) == TS_PHASE ? (float*)(F.ctl + CW_STAT) : (float*)nullptr)
#else
#define TS_SEL(k) ((float*)nullptr)
#endif
constexpr int RING_BYTES = 131072;
constexpr int TAB_OFF = RING_BYTES;
constexpr int PS_OFF = TAB_OFF + 8192;
constexpr int CN_OFF = PS_OFF + 320;
constexpr int CS_OFF = CN_OFF + 256;
constexpr int MISC_OFF = CS_OFF + 256;
constexpr int LDS_BYTES = 147456;
static_assert(MISC_OFF + 16 <= LDS_BYTES, "lds");
constexpr int MAXU = 4;

struct Frame {
    LAS unsigned char* lds; int tid, lane, wave, G, bid;
    unsigned* ctl;
    const float *x, *g_mix, *w_in, *w_s, *b_s, *g_sgu, *w_conv, *w_out, *g_ffn, *w_rg, *w_re, *wg, *wu, *wd, *g_final;
    float* out; float* x2; unsigned char* ws;
};

struct TJob { const float* src; bf16_t* dst; int ld, ldd; };
constexpr int NJ_IN = 16 * 56, NJ_OUT = 16 * 8, NJ_GU = 64 * 16 * 8, NJ_DN = 64 * 8 * 8, NJOBS = NJ_IN + NJ_OUT + NJ_GU + NJ_DN;
__device__ __forceinline__ TJob tjob(const Frame& F, int j) {
    TJob J;
    if (j < NJ_IN) { const int kt = j / 56, nt = j % 56, pn = nt >> 1, bj = nt & 1; int sc;
        if (pn < 8) sc = bj ? 5120 + 128 * pn : 128 * pn;
        else if (pn < 16) sc = bj ? 6144 + 128 * (pn - 8) : 2048 + 128 * (pn - 8);
        else if (pn < 24) sc = bj ? 4096 + 128 * (pn - 16) : 3072 + 128 * (pn - 16);
        else sc = 1024 + 256 * (pn - 24) + 128 * bj;
        J.src = F.w_in + (size_t)(kt * 64) * NP + sc; J.ld = NP; J.dst = (bf16_t*)(F.ws + WS_BT1) + (size_t)(nt * 128) * 1024 + kt * 64; J.ldd = 1024; return J; }
    j -= NJ_IN;
    if (j < NJ_OUT) { const int kt = j / 8, nt = j % 8;
        J.src = F.w_out + (size_t)(kt * 64) * D + nt * 128; J.ld = D; J.dst = (bf16_t*)(F.ws + WS_BT2) + (size_t)(nt * 128) * 1024 + kt * 64; J.ldd = 1024; return J; }
    j -= NJ_OUT;
    if (j < NJ_GU) { const int e = j / 128, r = j % 128, kt = r / 8, nt = r % 8, jj = nt >> 1, bj = nt & 1;
        J.src = (bj ? F.wu : F.wg) + (size_t)e * 1024 * 512 + (size_t)(kt * 64) * 512 + jj * 128; J.ld = 512;
        J.dst = (bf16_t*)(F.ws + WS_BTGU) + ((size_t)e * 1024 + jj * 256 + bj * 128) * 1024 + kt * 64; J.ldd = 1024; return J; }
    j -= NJ_GU;
    { const int e = j / 64, r = j % 64, kt = r / 8, nt = r % 8;
      J.src = F.wd + (size_t)e * 512 * 1024 + (size_t)(kt * 64) * 1024 + nt * 128; J.ld = 1024;
      J.dst = (bf16_t*)(F.ws + WS_BTD) + ((size_t)e * 1024 + nt * 128) * 512 + kt * 64; J.ldd = 512; return J; }
}
__device__ __forceinline__ unsigned off_b(unsigned row, unsigned ch) { return 256u * row + 16u * (ch ^ (((row & 3) << 2) | ((row >> 2) & 3))); }
__device__ __forceinline__ unsigned tr_read_addr_16(unsigned lane, unsigned c, unsigned ks, unsigned t) {
    const unsigned g = lane >> 4, q = (lane & 15) >> 2, p = lane & 3;
    return off_b(32 * ks + 8 * g + 4 * t + q, 2 * c + (p >> 1)) + 8 * (p & 1);
}
__device__ __forceinline__ void convert_jobs(const Frame& F, int jlo, int jhi) {
    LAS float* tile0 = (LAS float*)F.lds;
    const int kr = F.tid >> 5, n4 = (F.tid & 31) * 4;
    f32x4 v0[4], v1[4], v2[4];
#define CJ_LOAD(v, jj) do { if ((jj) < jhi) { const TJob J_ = tjob(F, (jj)); _Pragma("unroll") for (int p = 0; p < 4; ++p) v[p] = __builtin_nontemporal_load((const f32x4*)(J_.src + (size_t)(kr + 16 * p) * J_.ld + n4)); } } while (0)
#define CJ_STEP(v, jj, par) do { if ((jj) < jhi) { const TJob J_ = tjob(F, (jj)); LAS float* tile = tile0 + (par) * (64 * 129); \
        _Pragma("unroll") for (int p = 0; p < 4; ++p) { LAS float* d = tile + (kr + 16 * p) * 129 + n4; d[0] = v[p][0]; d[1] = v[p][1]; d[2] = v[p][2]; d[3] = v[p][3]; } \
        CJ_LOAD(v, (jj) + 3 * F.G); \
        __syncthreads(); \
        _Pragma("unroll") for (int rep = 0; rep < 2; ++rep) { const int n = (F.tid >> 3) + 64 * rep, k8 = (F.tid & 7) * 8; const LAS float* s_ = tile + k8 * 129 + n; \
            u32x4 o; o.x = cvt_pk_bf16(s_[0], s_[129]); o.y = cvt_pk_bf16(s_[2 * 129], s_[3 * 129]); o.z = cvt_pk_bf16(s_[4 * 129], s_[5 * 129]); o.w = cvt_pk_bf16(s_[6 * 129], s_[7 * 129]); \
            st_wt16(wt_rsrc(J_.dst), (unsigned)(((size_t)n * J_.ldd + k8) * 2), o); } } } while (0)
    int j = jlo + F.bid;
    CJ_LOAD(v0, j); CJ_LOAD(v1, j + F.G); CJ_LOAD(v2, j + 2 * F.G);
    for (; j < jhi; j += 6 * F.G) {
        CJ_STEP(v0, j, 0); CJ_STEP(v1, j + F.G, 1); CJ_STEP(v2, j + 2 * F.G, 0);
        CJ_STEP(v0, j + 3 * F.G, 1); CJ_STEP(v1, j + 4 * F.G, 0); CJ_STEP(v2, j + 5 * F.G, 1);
    }
    __syncthreads();
#undef CJ_LOAD
#undef CJ_STEP
}
constexpr float WSCALE = 64.0f, WSCALE_INV = 1.0f / 64.0f;
constexpr int NI_GU = 64 * 8 * 32, NI_DN = 64 * 4 * 32;
__device__ __forceinline__ void xitem(const Frame& F, int id, const float*& src, int& ld, unsigned char*& dst, int& ldd, int& k0) {
    if (id < NI_GU) { const int e = id >> 8, r = id & 255, kt = r >> 5, nb = r & 31, jj = nb >> 3, bj = (nb >> 2) & 1, sub = nb & 3;
        src = (bj ? F.wu : F.wg) + (size_t)e * 1024 * 512 + (size_t)(kt * 128) * 512 + jj * 128 + sub * 32; ld = 512; k0 = kt * 128;
        dst = F.ws + WS_BTGU + ((size_t)e * 1024 + nb * 32) * 1024 + kt * 128; ldd = 1024; }
    else { id -= NI_GU; const int e = id >> 7, r = id & 127, kt = r >> 5, nb = r & 31;
        src = F.wd + (size_t)e * 512 * 1024 + (size_t)(kt * 128) * 1024 + nb * 32; ld = 1024; k0 = -1;
        dst = F.ws + WS_BTD + ((size_t)e * 1024 + nb * 32) * 512 + kt * 128; ldd = 512; }
}
__device__ __forceinline__ void convert_experts_wave(const Frame& F, int item_lo, int item_hi, int widx, int wcnt) {
    LAS float* scr = (LAS float*)(F.lds + F.wave * 16896);
    const int gw = item_lo + widx, NGW = wcnt; const int NITEMS_X = item_hi;
    const int rr = F.lane >> 3, c4 = F.lane & 7;
    const int c16 = F.lane & 7, nr = F.lane >> 3;
    f32x4 va[16], vb[16];
#define XI_LOAD_U(v, id) do { const float* s_; int ld_; unsigned char* d_; int ldd_, k0_; xitem(F, (id), s_, ld_, d_, ldd_, k0_); \
        const __amdgpu_buffer_rsrc_t rs_ = __builtin_amdgcn_make_buffer_rsrc((void*)s_, (short)0, 0x7fffffff, 0x00020000); const int vo_ = (rr * ld_ + 4 * c4) * 4; \
        _Pragma("unroll") for (int i = 0; i < 16; ++i) v[i] = __builtin_bit_cast(f32x4, __builtin_amdgcn_raw_buffer_load_b128(rs_, vo_, i * 32 * ld_, 2  )); } while (0)
#define XI_LOAD(v, id) do { if ((id) < NITEMS_X) XI_LOAD_U(v, id); } while (0)
#define XI_STEP_B(v, id, NEXT) do { const float* s_; int ld_; unsigned char* d_; int ldd_, k0_; xitem(F, (id), s_, ld_, d_, ldd_, k0_); \
        f32x4 g_[4]; { const float* gp_ = F.g_ffn + (k0_ >= 0 ? k0_ : 0) + 16 * c16; const float gm_ = k0_ >= 0 ? WSCALE : 0.f, ga_ = k0_ >= 0 ? 0.f : WSCALE; \
            _Pragma("unroll") for (int q = 0; q < 4; ++q) g_[q] = *(const f32x4*)(gp_ + 4 * q); \
        _Pragma("unroll") for (int i = 0; i < 16; ++i) { LAS float* w_ = scr + (8 * i + rr) * 33 + 4 * c4; w_[0] = v[i][0]; w_[1] = v[i][1]; w_[2] = v[i][2]; w_[3] = v[i][3]; } \
        if ((NEXT) > 0) XI_LOAD_U(v, (id) + 2 * NGW); else if ((NEXT) < 0) XI_LOAD(v, (id) + 2 * NGW); \
        _Pragma("unroll") for (int q = 0; q < 4; ++q) g_[q] = g_[q] * gm_ + ga_; }     \
        _Pragma("unroll") for (int j = 0; j < 4; ++j) { const int n = nr + 8 * j; const LAS float* t_ = scr + (16 * c16) * 33 + n; u32x4 o; \
            o.x = pk4_fp8(t_[0] * g_[0][0], t_[33] * g_[0][1], t_[2 * 33] * g_[0][2], t_[3 * 33] * g_[0][3]); o.y = pk4_fp8(t_[4 * 33] * g_[1][0], t_[5 * 33] * g_[1][1], t_[6 * 33] * g_[1][2], t_[7 * 33] * g_[1][3]); \
            o.z = pk4_fp8(t_[8 * 33] * g_[2][0], t_[9 * 33] * g_[2][1], t_[10 * 33] * g_[2][2], t_[11 * 33] * g_[2][3]); o.w = pk4_fp8(t_[12 * 33] * g_[3][0], t_[13 * 33] * g_[3][1], t_[14 * 33] * g_[3][2], t_[15 * 33] * g_[3][3]); \
            __builtin_amdgcn_raw_buffer_store_b128(__builtin_bit_cast(bl4_t, o), wt_rsrc(d_), n * ldd_ + 16 * c16, 0, 18  ); } } while (0)
    int id = gw;
    if (id + 3 * NGW < NITEMS_X) {
        XI_LOAD_U(va, id); XI_LOAD_U(vb, id + NGW);
        do { XI_STEP_B(va, id, 1); XI_STEP_B(vb, id + NGW, 1); id += 2 * NGW; } while (id + 3 * NGW < NITEMS_X);
    } else { XI_LOAD(va, id); XI_LOAD(vb, id + NGW); }
    for (; id < NITEMS_X; id += 2 * NGW) { XI_STEP_B(va, id, -1); if (id + NGW < NITEMS_X) XI_STEP_B(vb, id + NGW, -1); }
#undef XI_LOAD
#undef XI_LOAD_U
#undef XI_STEP_B
    __syncthreads();
}
__device__ __forceinline__ void phase_prologue(const Frame& F) {
    convert_jobs(F, 0, NJ_IN + NJ_OUT);
    { bf16_t* hi = (bf16_t*)(F.ws + WS_WR); bf16_t* lo = hi + 80 * 1024;
      for (int i = F.bid * NTHR + F.tid; i < 80 * 1024; i += F.G * NTHR) { const int jj = i >> 10, c = i & 1023;
          float w = 0.f; if (jj < 64) w = F.w_re[c * 64 + jj] * F.g_ffn[c]; else if (jj < 72) w = F.w_rg[c * 8 + (jj - 64)] * F.g_ffn[c];
          const unsigned h = cvt_pk_bf16(w, 0.f) & 0xffffu; const float r = w - __uint_as_float(h << 16);
          hi[i] = (bf16_t)h; lo[i] = (bf16_t)(cvt_pk_bf16(r, 0.f) & 0xffffu); } }
    { bf16_t* o = (bf16_t*)(F.ws + WS_WSB);
      for (int i = F.bid * NTHR + F.tid; i < 8 * 128 * 128; i += F.G * NTHR) o[i] = (bf16_t)(cvt_pk_bf16(F.w_s[i], 0.f) & 0xffffu); }
    { bf16_t* H = (bf16_t*)(F.ws + WS_H);
      f32x4 g[4];
#pragma unroll
      for (int q = 0; q < 4; ++q) g[q] = *(const f32x4*)(F.g_mix + 4 * F.lane + 256 * q);
      for (int row = F.bid * NWAVES + F.wave; row < T; row += F.G * NWAVES) {
          const float* xr = F.x + (size_t)row * D + 4 * F.lane; f32x4 a[4]; float s = 0.f;
#pragma unroll
          for (int q = 0; q < 4; ++q) { a[q] = *(const f32x4*)(xr + 256 * q); s += (a[q][0] * a[q][0] + a[q][1] * a[q][1]) + (a[q][2] * a[q][2] + a[q][3] * a[q][3]); }
          const float r = 1.0f / sqrtf(wave_sum(s) * (1.0f / D) + EPS);
#pragma unroll
          for (int q = 0; q < 4; ++q) { u32x2 o; o.x = cvt_pk_bf16(a[q][0] * r * g[q][0], a[q][1] * r * g[q][1]); o.y = cvt_pk_bf16(a[q][2] * r * g[q][2], a[q][3] * r * g[q][3]);
              st_wt8(wt_rsrc(H), (unsigned)(((size_t)row * D + 4 * F.lane + 256 * q) * 2), o); }
      } }
}

struct ProbProj {
    static constexpr int K = 1024, A_AUX = 0; static constexpr bool PERM = true, GATHER = false, AFTER_DRAIN = false, FP8 = false;
    const bf16_t* A; const bf16_t* Bt; pg8::StaticOrder so; bf16_t *Pp, *Qp, *Rp, *Vp; int ilo, ihi;
    __device__ __forceinline__ bool next(int i, pg8::Unit& u) const { int pm, pn; if (ilo + i >= ihi || !so.next(ilo + i, pm, pn)) return false; u.m0 = pm; u.n0 = pn; u.e = 0; u.cnt = 0; u.lb = 0;
        u.a = (const char*)A + (size_t)pm * 256 * K * 2; u.b = (const char*)Bt + (size_t)pn * 256 * K * 2; return true; }
    __device__ __forceinline__ unsigned row_off(const pg8::Unit&, int) const { return 0u; }
    template <int TY> __device__ __forceinline__ void epi_t(const f32x4 (&acc)[2][2][4][2], const pg8::Unit& u, int wr, int wc, int fr, int fq) const {
        const int row0 = u.m0 * 256 + wr * 64 + fr, cl = wc * 32 + 8 * fq;
        bf16_t* dst = Pp + (size_t)TY * ((32 * MiB) / 2) + (u.n0 & 7) * 128 + cl;
#pragma unroll
        for (int ai = 0; ai < 2; ++ai)
#pragma unroll
            for (int m = 0; m < 4; ++m) {
                f32x2 o[4];
#pragma unroll
                for (int n = 0; n < 2; ++n)
#pragma unroll
                    for (int q = 0; q < 2; ++q) { const f32x2 X = (f32x2){acc[ai][0][m][n][2 * q], acc[ai][0][m][n][2 * q + 1]}, Y = (f32x2){acc[ai][1][m][n][2 * q], acc[ai][1][m][n][2 * q + 1]};
                        o[n * 2 + q] = (TY == 0) ? gelu_sig_pk(X, Y) : ((TY == 1) ? mul_sig_pk(X, Y) : X * Y); }
                u32x4 w; w.x = cvt_pk_bf16(o[0].x, o[0].y); w.y = cvt_pk_bf16(o[1].x, o[1].y); w.z = cvt_pk_bf16(o[2].x, o[2].y); w.w = cvt_pk_bf16(o[3].x, o[3].y);
                *(u32x4*)(dst + (size_t)(row0 + ai * 128 + m * 16) * D) = w; }
    }
    __device__ __forceinline__ void epi(const f32x4 (&acc)[2][2][4][2], const pg8::Unit& u, int wr, int wc, int fr, int fq) const {
        const int pn = u.n0, row0 = u.m0 * 256 + wr * 64 + fr, cl = wc * 32 + 8 * fq;
        if (pn < 8) epi_t<0>(acc, u, wr, wc, fr, fq);
        else if (pn < 16) epi_t<1>(acc, u, wr, wc, fr, fq);
        else if (pn < 24) epi_t<2>(acc, u, wr, wc, fr, fq);
        else {
            bf16_t* dst = Vp + (pn - 24) * 256 + cl;
#pragma unroll
            for (int ai = 0; ai < 2; ++ai)
#pragma unroll
                for (int m = 0; m < 4; ++m)
#pragma unroll
                    for (int bj = 0; bj < 2; ++bj) {
                        f32x2 o[4];
#pragma unroll
                        for (int n = 0; n < 2; ++n)
#pragma unroll
                            for (int q = 0; q < 2; ++q) o[n * 2 + q] = gelu_pk2((f32x2){acc[ai][bj][m][n][2 * q], acc[ai][bj][m][n][2 * q + 1]});
                        u32x4 w; w.x = cvt_pk_bf16(o[0].x, o[0].y); w.y = cvt_pk_bf16(o[1].x, o[1].y); w.z = cvt_pk_bf16(o[2].x, o[2].y); w.w = cvt_pk_bf16(o[3].x, o[3].y);
                        *(u32x4*)(dst + (size_t)(row0 + ai * 128 + m * 16) * D + bj * 128) = w; }
        }
    }
};

__device__ __forceinline__ float row16_sum(float x) {
    x += __builtin_bit_cast(float, __builtin_amdgcn_update_dpp(0, __builtin_bit_cast(int, x), 0xB1, 0xF, 0xF, true));
    x += __builtin_bit_cast(float, __builtin_amdgcn_update_dpp(0, __builtin_bit_cast(int, x), 0x4E, 0xF, 0xF, true));
    x += __builtin_bit_cast(float, __builtin_amdgcn_update_dpp(0, __builtin_bit_cast(int, x), 0x141, 0xF, 0xF, true));
    x += __builtin_bit_cast(float, __builtin_amdgcn_update_dpp(0, __builtin_bit_cast(int, x), 0x140, 0xF, 0xF, true));
    return x;
}
__device__ __forceinline__ void phase_sgu(const Frame& F) {
    const bf16_t* Pp = (const bf16_t*)(F.ws + WS_P); const bf16_t* Qp = (const bf16_t*)(F.ws + WS_Q); const bf16_t* Rp = (const bf16_t*)(F.ws + WS_R); const bf16_t* Vp = (const bf16_t*)(F.ws + WS_V);
    const bf16_t* Wsb = (const bf16_t*)(F.ws + WS_WSB); bf16_t* Mg = (bf16_t*)(F.ws + WS_H);
    LAS unsigned char* VT = F.lds;
    LAS float* ZB = (LAS float*)(F.lds + 32768);
    LAS unsigned char* RT = F.lds + 32768 + 128 * 132 * 4;
    const int ch = F.tid & 15, pr = F.tid >> 4;
    const unsigned vbase = (unsigned)(size_t)VT;
    typedef unsigned bl4_t __attribute__((__vector_size__(16)));
    const __amdgpu_buffer_rsrc_t rsM = __builtin_amdgcn_make_buffer_rsrc((void*)Mg, (short)0, 0x7fffffff, 0x00020000);
    u32x4 vnx[4];
    const int sq0 = 16 * (F.bid & 7) + (F.bid >> 6);
    if (F.bid < 1024) { const int t0 = sq0 * 128, c0 = ((F.bid >> 3) & 7) * 128;
#pragma unroll
        for (int ps = 0; ps < 4; ++ps) vnx[ps] = *(const u32x4*)(Vp + (size_t)(t0 + pr + 32 * ps) * D + c0 + 8 * ch); }
    const int g = (F.bid >> 3) & 7, c0 = g * 128;
    const int q0 = 16 * F.wave; const int l15 = F.lane & 15, lq = F.lane >> 4;
    float gs[8], w0[8], w1[8], w2[8];
#pragma unroll
    for (int q = 0; q < 2; ++q) { const f32x4 t4 = *(const f32x4*)(F.g_sgu + c0 + 8 * ch + 4 * q); gs[4 * q] = t4[0]; gs[4 * q + 1] = t4[1]; gs[4 * q + 2] = t4[2]; gs[4 * q + 3] = t4[3];
        const f32x4 a = *(const f32x4*)(F.w_conv + c0 + 8 * ch + 4 * q), b = *(const f32x4*)(F.w_conv + 1024 + c0 + 8 * ch + 4 * q), c = *(const f32x4*)(F.w_conv + 2048 + c0 + 8 * ch + 4 * q);
#pragma unroll
        for (int i = 0; i < 4; ++i) { w0[4 * q + i] = a[i]; w1[4 * q + i] = b[i]; w2[4 * q + i] = c[i]; } }
    bf16x8 Yf[4];
#pragma unroll
    for (int ks = 0; ks < 4; ++ks) Yf[ks] = *(const bf16x8*)(Wsb + (size_t)(g * 128 + q0 + l15) * 128 + 32 * ks + 8 * lq);
    const float bq = F.b_s[g * 128 + q0 + l15];
    for (int unit = F.bid; unit < 1024; unit += F.G) {
        const int chunk = sq0 + 4 * (unit / F.G), t0 = chunk * 128;
        u32x4 pvv[4], qvv[4], r0v[4];
#pragma unroll
        for (int ps = 0; ps < 4; ++ps) r0v[ps] = *(const u32x4*)(Rp + (size_t)(t0 + pr + 32 * ps) * D + c0 + 8 * ch);
        const u32x4 rmh = *(const u32x4*)(Rp + (size_t)(t0 > 0 ? t0 - 1 : 0) * D + c0 + 8 * ch), rph = *(const u32x4*)(Rp + (size_t)(t0 + 128 < T ? t0 + 128 : T - 1) * D + c0 + 8 * ch);
#pragma unroll
        for (int ps = 0; ps < 4; ++ps) { const size_t o = (size_t)(t0 + pr + 32 * ps) * D + c0 + 8 * ch; pvv[ps] = *(const u32x4*)(Pp + o); qvv[ps] = *(const u32x4*)(Qp + o); }
#pragma unroll
        for (int ps = 0; ps < 4; ++ps) {
            const int p = pr + 32 * ps;
            const u32x4 raw = vnx[ps];
            float v[8]; v[0] = bf_lo(raw.x); v[1] = bf_hi(raw.x); v[2] = bf_lo(raw.y); v[3] = bf_hi(raw.y); v[4] = bf_lo(raw.z); v[5] = bf_hi(raw.z); v[6] = bf_lo(raw.w); v[7] = bf_hi(raw.w);
            float s = ((v[0] + v[1]) + (v[2] + v[3])) + ((v[4] + v[5]) + (v[6] + v[7]));
            s = row16_sum(s);
            const float mean = s * (1.0f / 128.f); float qv = 0.f;
#pragma unroll
            for (int i = 0; i < 8; ++i) { v[i] -= mean; qv += v[i] * v[i]; }
            qv = row16_sum(qv);
            const float r = 1.0f / sqrtf(qv * (1.0f / 128.f) + EPS);
            u32x4 o; o.x = cvt_pk_bf16(v[0] * r * gs[0], v[1] * r * gs[1]); o.y = cvt_pk_bf16(v[2] * r * gs[2], v[3] * r * gs[3]);
            o.z = cvt_pk_bf16(v[4] * r * gs[4], v[5] * r * gs[5]); o.w = cvt_pk_bf16(v[6] * r * gs[6], v[7] * r * gs[7]);
            *(LAS u32x4*)(VT + off_b(p, ch)) = o;
        }
        __syncthreads();
        if (unit + F.G < 1024) { const int tn = (chunk + 4) * 128, cn = c0;
#pragma unroll
            for (int ps = 0; ps < 4; ++ps) vnx[ps] = *(const u32x4*)(Vp + (size_t)(tn + pr + 32 * ps) * D + cn + 8 * ch); }
        {
#define SG_ISSUE(ct, S) do { const unsigned a0_ = vbase + tr_read_addr_16(F.lane, (ct), 0, 0), a1_ = vbase + tr_read_addr_16(F.lane, (ct), 0, 1); \
            asm volatile("ds_read_b64_tr_b16 %0, %8\n\tds_read_b64_tr_b16 %1, %9\n\tds_read_b64_tr_b16 %2, %8 offset:8192\n\tds_read_b64_tr_b16 %3, %9 offset:8192\n\t" \
                         "ds_read_b64_tr_b16 %4, %8 offset:16384\n\tds_read_b64_tr_b16 %5, %9 offset:16384\n\tds_read_b64_tr_b16 %6, %8 offset:24576\n\tds_read_b64_tr_b16 %7, %9 offset:24576" \
                         : "=&v"(S[0]), "=&v"(S[1]), "=&v"(S[2]), "=&v"(S[3]), "=&v"(S[4]), "=&v"(S[5]), "=&v"(S[6]), "=&v"(S[7]) : "v"(a0_), "v"(a1_) : "memory"); } while (0)
#define SG_USE(ct, S, NWAIT) do { asm volatile("s_waitcnt lgkmcnt(" #NWAIT ")" ::: "memory"); \
            asm volatile("" : "+v"(S[0]), "+v"(S[1]), "+v"(S[2]), "+v"(S[3]), "+v"(S[4]), "+v"(S[5]), "+v"(S[6]), "+v"(S[7])); \
            f32x4 acc_ = (f32x4){0.f, 0.f, 0.f, 0.f}; \
            _Pragma("unroll") for (int ks = 0; ks < 4; ++ks) { const u16x4 lo_ = S[2 * ks], hi_ = S[2 * ks + 1]; \
                const bf16x8 X_ = (bf16x8){(short)lo_[0], (short)lo_[1], (short)lo_[2], (short)lo_[3], (short)hi_[0], (short)hi_[1], (short)hi_[2], (short)hi_[3]}; \
                acc_ = __builtin_amdgcn_mfma_f32_16x16x32_bf16(X_, Yf[ks], acc_, 0, 0, 0); } \
            acc_ = acc_ + bq; *(LAS f32x4*)(ZB + (q0 + l15) * 132 + 16 * (ct) + 4 * lq) = acc_; } while (0)
            u16x4 SA[8], SB[8];
            SG_ISSUE(0, SA);
            SG_ISSUE(1, SB); SG_USE(0, SA, 8);
            SG_ISSUE(2, SA); SG_USE(1, SB, 8);
            SG_ISSUE(3, SB); SG_USE(2, SA, 8);
            SG_ISSUE(4, SA); SG_USE(3, SB, 8);
            SG_ISSUE(5, SB); SG_USE(4, SA, 8);
            SG_ISSUE(6, SA); SG_USE(5, SB, 8);
            SG_ISSUE(7, SB); SG_USE(6, SA, 8);
            SG_USE(7, SB, 0);
#undef SG_ISSUE
#undef SG_USE
        }
#pragma unroll
        for (int ps = 0; ps < 4; ++ps) *(LAS u32x4*)(RT + (pr + 32 * ps) * 256 + 16 * ch) = r0v[ps];
        __syncthreads();
        {
#pragma unroll
            for (int ps = 0; ps < 4; ++ps) {
                const int q = pr + 32 * ps, t = t0 + q; const size_t o = (size_t)t * D + c0 + 8 * ch; const int ts = t & (SEQ - 1);
                const u32x4 zero4 = (u32x4){0u, 0u, 0u, 0u};
                const u32x4 pv = pvv[ps], qv = qvv[ps], r0 = r0v[ps];
                u32x4 rm = (ps == 0 && pr == 0) ? rmh : *(const LAS u32x4*)(RT + (q > 0 ? q - 1 : 0) * 256 + 16 * ch);
                u32x4 rp = (ps == 3 && pr == 31) ? rph : *(const LAS u32x4*)(RT + (q < 127 ? q + 1 : 127) * 256 + 16 * ch);
                if (ts == 0) rm = zero4;
                if (ts == SEQ - 1) rp = zero4;
                const f32x4 z0 = *(const LAS f32x4*)(ZB + q * 132 + 8 * ch), z1 = *(const LAS f32x4*)(ZB + q * 132 + 8 * ch + 4);
                float zz[8] = {z0[0], z0[1], z0[2], z0[3], z1[0], z1[1], z1[2], z1[3]};
                float res[8];
#pragma unroll
                for (int i = 0; i < 4; ++i) {
                    const unsigned pw = pv[i], qw = qv[i], rmw = rm[i], r0w = r0[i], rpw = rp[i];
                    res[2 * i] = bf_lo(pw) * zz[2 * i] + bf_lo(qw) * (w0[2 * i] * bf_lo(rmw) + w1[2 * i] * bf_lo(r0w) + w2[2 * i] * bf_lo(rpw));
                    res[2 * i + 1] = bf_hi(pw) * zz[2 * i + 1] + bf_hi(qw) * (w0[2 * i + 1] * bf_hi(rmw) + w1[2 * i + 1] * bf_hi(r0w) + w2[2 * i + 1] * bf_hi(rpw));
                }
                u32x4 w; w.x = cvt_pk_bf16(res[0], res[1]); w.y = cvt_pk_bf16(res[2], res[3]); w.z = cvt_pk_bf16(res[4], res[5]); w.w = cvt_pk_bf16(res[6], res[7]);
                __builtin_amdgcn_raw_buffer_store_b128(__builtin_bit_cast(bl4_t, w), rsM, (int)(o * 2), 0, 16  );
            }
        }
        __syncthreads();
    }
}

struct ProbOut {
    static constexpr int K = 1024, A_AUX = 16  ; static constexpr bool PERM = true, GATHER = false, AFTER_DRAIN = true, FP8 = false;
    const bf16_t* A; const bf16_t* Bt; pg8::StaticOrder so; const float* x; bf16_t* H2; unsigned char* X8; const bf16_t* WRh; float* PLG;
    __device__ __forceinline__ bool next(int i, pg8::Unit& u) const { int pm, pn; if (i > 0 || !so.next(i, pm, pn)) return false; u.m0 = pm; u.n0 = pn; u.e = 0; u.cnt = 0; u.lb = 0;
        u.a = (const char*)A + (size_t)pm * 256 * K * 2; u.b = (const char*)Bt + (size_t)pn * 256 * K * 2; return true; }
    __device__ __forceinline__ unsigned row_off(const pg8::Unit&, int) const { return 0u; }
    __device__ __forceinline__ void epi(const f32x4 (&)[2][2][4][2], const pg8::Unit&, int, int, int, int) const {}
    __device__ __forceinline__ void epi_drain(f32x4 (&acc)[2][2][4][2], const pg8::Unit& u, int wr, int wc, int fr, int fq, LAS unsigned char* lds) const {
        const int tid = (wr * 4 + wc) * 64 + fq * 16 + fr;
        const int row0 = u.m0 * 256 + wr * 64 + fr, col0 = u.n0 * 256 + wc * 32 + 8 * fq;
        LAS float* PB = (LAS float*)lds;
        LAS float* SSP = (LAS float*)(lds + TAB_OFF);
        f32x4 xq[2][4];
#define PO_XLOAD(B, it_) do { const size_t o_ = (size_t)(row0 + ((it_) >> 2) * 128 + ((it_) & 3) * 16) * D + col0; \
            xq[B][0] = *(const f32x4*)(x + o_); xq[B][1] = *(const f32x4*)(x + o_ + 4); xq[B][2] = *(const f32x4*)(x + o_ + 128); xq[B][3] = *(const f32x4*)(x + o_ + 132); } while (0)
        PO_XLOAD(0, 0);
#pragma unroll
        for (int it = 0; it < 8; ++it) {
            const int ai = it >> 2, m = it & 3, B = it & 1;
            if (it + 1 < 8) PO_XLOAD(B ^ 1, it + 1);
            float ss = 0.f;
#pragma unroll
            for (int bj = 0; bj < 2; ++bj) {
                const size_t o = (size_t)(row0 + ai * 128 + m * 16) * D + col0 + bj * 128;
                const f32x4 v0 = acc[ai][bj][m][0] + xq[B][2 * bj], v1 = acc[ai][bj][m][1] + xq[B][2 * bj + 1];
                ss += (v0[0] * v0[0] + v0[1] * v0[1]) + (v0[2] * v0[2] + v0[3] * v0[3]) + (v1[0] * v1[0] + v1[1] * v1[1]) + (v1[2] * v1[2] + v1[3] * v1[3]);
                u32x4 h; h.x = cvt_pk_bf16(v0[0], v0[1]); h.y = cvt_pk_bf16(v0[2], v0[3]); h.z = cvt_pk_bf16(v1[0], v1[1]); h.w = cvt_pk_bf16(v1[2], v1[3]);
                *(u32x4*)(H2 + o) = h;
                { u32x2 e8; e8.x = pk4_fp8(v0[0], v0[1], v0[2], v0[3]); e8.y = pk4_fp8(v1[0], v1[1], v1[2], v1[3]); *(u32x2*)(X8 + o) = e8; }
                u32x4 l; l.x = cvt_pk_bf16(v0[0] - bf_lo(h.x), v0[1] - bf_hi(h.x)); l.y = cvt_pk_bf16(v0[2] - bf_lo(h.y), v0[3] - bf_hi(h.y));
                l.z = cvt_pk_bf16(v1[0] - bf_lo(h.z), v1[1] - bf_hi(h.z)); l.w = cvt_pk_bf16(v1[2] - bf_lo(h.w), v1[3] - bf_hi(h.w));
                acc[ai][bj][m][0] = __builtin_bit_cast(f32x4, h); acc[ai][bj][m][1] = __builtin_bit_cast(f32x4, l);
            }
            ss += __shfl_xor(ss, 16); ss += __shfl_xor(ss, 32);
            if (fq == 0) SSP[wc * 256 + ai * 128 + wr * 64 + m * 16 + fr] = ss;
        }
#undef PO_XLOAD
        const int rrow = tid >> 1, rhalf = tid & 1;
        float* prow = PLG + ((size_t)(u.m0 * 256 + rrow) * 4 + u.n0) * PLW;
        bf16x8 Wn[2][2];
#pragma unroll
        for (int bj = 0; bj < 2; ++bj) { const bf16_t* wp = WRh + (size_t)fr * 1024 + u.n0 * 256 + bj * 128 + wc * 32 + 8 * fq; Wn[bj][0] = *(const bf16x8*)wp; Wn[bj][1] = *(const bf16x8*)(wp + 80 * 1024); }
#pragma unroll 1
        for (int jt = 0; jt < 5; ++jt) {
            bf16x8 Wf[2][2];
#pragma unroll
            for (int bj = 0; bj < 2; ++bj) { Wf[bj][0] = Wn[bj][0]; Wf[bj][1] = Wn[bj][1]; }
            { const int jn = jt < 4 ? jt + 1 : 4;
#pragma unroll
              for (int bj = 0; bj < 2; ++bj) { const bf16_t* wp = WRh + (size_t)(16 * jn + fr) * 1024 + u.n0 * 256 + bj * 128 + wc * 32 + 8 * fq; Wn[bj][0] = *(const bf16x8*)wp; Wn[bj][1] = *(const bf16x8*)(wp + 80 * 1024); } }
            LAS float* pb = PB + (jt & 1) * (4 * 256 * 16) + wc * (256 * 16);
#pragma unroll
            for (int ai = 0; ai < 2; ++ai)
#pragma unroll
                for (int m = 0; m < 4; ++m) {
                    f32x4 d = (f32x4){0.f, 0.f, 0.f, 0.f};
#pragma unroll
                    for (int bj = 0; bj < 2; ++bj) { const bf16x8 xh = __builtin_bit_cast(bf16x8, acc[ai][bj][m][0]), xl = __builtin_bit_cast(bf16x8, acc[ai][bj][m][1]);
                        d = __builtin_amdgcn_mfma_f32_16x16x32_bf16(Wf[bj][0], xh, d, 0, 0, 0);
                        d = __builtin_amdgcn_mfma_f32_16x16x32_bf16(Wf[bj][0], xl, d, 0, 0, 0);
                        d = __builtin_amdgcn_mfma_f32_16x16x32_bf16(Wf[bj][1], xh, d, 0, 0, 0); }
                    *(LAS f32x4*)(pb + (ai * 128 + wr * 64 + m * 16 + fr) * 16 + 4 * fq) = d;
                }
            __syncthreads();
            { const LAS float* q = PB + (jt & 1) * (4 * 256 * 16) + rrow * 16 + 8 * rhalf;
              f32x4 s0 = *(const LAS f32x4*)q, s1 = *(const LAS f32x4*)(q + 4);
#pragma unroll
              for (int w = 1; w < 4; ++w) { s0 = s0 + *(const LAS f32x4*)(q + w * 256 * 16); s1 = s1 + *(const LAS f32x4*)(q + w * 256 * 16 + 4); }
              *(f32x4*)(prow + 16 * jt + 8 * rhalf) = s0; *(f32x4*)(prow + 16 * jt + 8 * rhalf + 4) = s1;
              if (jt == 0 && rhalf == 0) prow[80] = (SSP[rrow] + SSP[256 + rrow]) + (SSP[512 + rrow] + SSP[768 + rrow]); }
        }
    }
};

__device__ __forceinline__ void phase_router(const Frame& F) {
    const float* PLG = (const float*)(F.ws + WS_PLG);
    int* ltok = (int*)(F.ws + WS_LTOK); float* lw = (float*)(F.ws + WS_LW); float* lrs = (float*)(F.ws + WS_LRS); float* route = (float*)(F.ws + WS_ROUTE);
    unsigned* gcnt = F.ctl + CW_GCNT;
    LAS float* LG = (LAS float*)F.lds;
    LAS int* hist = (LAS int*)(F.lds + 64 * PLW * 4);
    LAS int* base = hist + 64;
    for (int u_ = F.bid; u_ < T / 64; u_ += F.G) {
        const int unit = (u_ & 7) * 32 + (u_ >> 3);
        {
            constexpr int NQ = PLW / 4, NTASK = 64 * NQ;
            const __amdgpu_buffer_rsrc_t rsL = wt_rsrc(PLG);
            f32x4 pv[3][4];
#pragma unroll
            for (int k = 0; k < 3; ++k) { const int e = F.tid + k * NTHR; if (e < NTASK) { const int tt = e / NQ, q = e - tt * NQ; const int o_ = (int)((((size_t)(unit * 64 + tt) * 4) * PLW + 4 * q) * 4);
#pragma unroll
                    for (int w = 0; w < 4; ++w) pv[k][w] = __builtin_bit_cast(f32x4, __builtin_amdgcn_raw_buffer_load_b128(rsL, o_ + w * PLW * 4, 0, 16  )); } }
#pragma unroll
            for (int k = 0; k < 3; ++k) { const int e = F.tid + k * NTHR; if (e < NTASK) *(LAS f32x4*)(LG + 4 * e) = (pv[k][0] + pv[k][1]) + (pv[k][2] + pv[k][3]); }
        }
        if (F.tid < 64) hist[F.tid] = 0;
        __syncthreads();
        int e0 = 0, e1 = 0, lp0 = 0, lp1 = 0; float w0 = 0.f, w1 = 0.f, rstd = 0.f;
        if (F.tid < 64) {
            const LAS float* l0 = LG + F.tid * PLW;
            rstd = 1.0f / sqrtf(l0[80] * (1.0f / D) + EPS);
            int gi = 0; float gm = l0[64] * rstd;
#pragma unroll
            for (int j = 1; j < 8; ++j) { const float v = l0[64 + j] * rstd; if (v > gm) { gm = v; gi = j; } }
            float den = 0.f;
#pragma unroll
            for (int j = 0; j < 8; ++j) den += __expf(l0[64 + j] * rstd - gm);
            const float pg = 1.0f / den;
            const LAS float* ep = l0 + gi * 8;
            int i1 = 0; float m1 = ep[0] * rstd;
#pragma unroll
            for (int j = 1; j < 8; ++j) { const float v = ep[j] * rstd; if (v > m1) { m1 = v; i1 = j; } }
            int i2 = -1; float m2 = 0.f;
#pragma unroll
            for (int j = 0; j < 8; ++j) { const float v = ep[j] * rstd; if (j != i1 && (i2 < 0 || v > m2)) { m2 = v; i2 = j; } }
            const float ex = __expf(m2 - m1);
            e0 = gi * 8 + i1; e1 = gi * 8 + i2; w0 = pg / (1.0f + ex); w1 = pg * ex / (1.0f + ex);
            lp0 = __hip_atomic_fetch_add(hist + e0, 1, __ATOMIC_RELAXED, __HIP_MEMORY_SCOPE_WORKGROUP);
            lp1 = __hip_atomic_fetch_add(hist + e1, 1, __ATOMIC_RELAXED, __HIP_MEMORY_SCOPE_WORKGROUP);
        }
        __syncthreads();
        if (F.tid < 64) { const int hc = hist[F.tid]; base[F.tid] = hc ? (int)__hip_atomic_fetch_add(gcnt + 16 * F.tid, (unsigned)hc, RLX_AGENT) : 0; }
        __syncthreads();
        if (F.tid < 64) {
            const int t = unit * 64 + F.tid;
            const int p0 = base[e0] + lp0, p1 = base[e1] + lp1;
            ltok[e0 * LCAP + p0] = 2 * t; lw[e0 * LCAP + p0] = w0; lrs[e0 * LCAP + p0] = rstd;
            ltok[e1 * LCAP + p1] = 2 * t + 1; lw[e1 * LCAP + p1] = w1; lrs[e1 * LCAP + p1] = rstd;
            *(f32x4*)(route + (size_t)t * 4) = (f32x4){(float)e0, (float)e1, w0, w1};
            ((int*)(F.ws + WS_ROUTE2))[2 * t] = p0; ((int*)(F.ws + WS_ROUTE2))[2 * t + 1] = p1;
        }
        __syncthreads();
    }
}

__device__ __forceinline__ void moe_tables(const Frame& F) {
    LAS int* ps = (LAS int*)(F.lds + PS_OFF); LAS int* cn = (LAS int*)(F.lds + CN_OFF);
    if (F.tid < 64) {
        const int c = (int)__hip_atomic_load(F.ctl + CW_GCNT + 16 * F.tid, RLX_AGENT); cn[F.tid] = c;
        int nb = (c + 255) >> 8, incl = nb;
#pragma unroll
        for (int o = 1; o < 64; o <<= 1) { const int v = __shfl_up(incl, o); if (F.lane >= o) incl += v; }
        ps[F.tid] = incl - nb; if (F.tid == 63) ps[64] = incl;
        int ci = c;
#pragma unroll
        for (int o = 1; o < 64; o <<= 1) { const int v = __shfl_up(ci, o); if (F.lane >= o) ci += v; }
        ((LAS int*)(F.lds + CS_OFF))[F.tid] = ci - c;
    }
    __syncthreads();
}
struct MoeOrder {
    LAS const int* ps; LAS const int* cn; int nunits, G, c;
    __device__ __forceinline__ bool locate(int i, int& blk, int& j, int& e, int& bin) const {
        const int L = i * G + c; if (L >= nunits) return false;
        const int id = pg8::xcd_remap(L, nunits); blk = id >> 2; j = id & 3;
        const int lane = lane_id_fresh();
        const unsigned long long m = __ballot(ps[lane] <= blk);
        e = __builtin_amdgcn_readfirstlane(__builtin_popcountll(m) - 1); bin = blk - __builtin_amdgcn_readfirstlane(ps[e]); return true;
    }
};
struct ProbGU {
    static constexpr int K = 512, A_AUX = 0; static constexpr bool PERM = true, GATHER = true, AFTER_DRAIN = false, FP8 = true;
    const unsigned char* H2; const unsigned char* Bt; unsigned char* HID; LAS const int* tab; MoeOrder mo;
    __device__ __forceinline__ bool next(int i, pg8::Unit& u) const { int blk, j, e, bin; if (!mo.locate(i, blk, j, e, bin)) return false;
        u.m0 = blk; u.n0 = j; u.e = i; u.cnt = __builtin_amdgcn_readfirstlane(mo.cn[e]) - bin * 256; u.lb = e * LCAP + bin * 256;
        u.a = (const char*)H2; u.b = (const char*)Bt + ((size_t)e * 1024 + j * 256) * K * 2; return true; }
    __device__ __forceinline__ unsigned row_off(const pg8::Unit& u, int r) const { return (unsigned)tab[u.e * 256 + r] * (unsigned)(K * 2); }
    __device__ __forceinline__ void epi(const f32x4 (&acc)[2][2][4][2], const pg8::Unit& u, int wr, int wc, int fr, int fq) const {
        const int hc = u.n0 * 128 + wc * 32 + 8 * fq;
#pragma unroll
        for (int ai = 0; ai < 2; ++ai)
#pragma unroll
            for (int m = 0; m < 4; ++m) {
                const int rl = ai * 128 + wr * 64 + m * 16 + fr;
                const float rs = ((LAS const float*)tab)[1024 + u.e * 256 + rl] * WSCALE_INV;
                f32x2 o[4];
#pragma unroll
                for (int n = 0; n < 2; ++n)
#pragma unroll
                    for (int q = 0; q < 2; ++q) { const f32x2 gt = (f32x2){acc[ai][0][m][n][2 * q], acc[ai][0][m][n][2 * q + 1]} * rs, up = (f32x2){acc[ai][1][m][n][2 * q], acc[ai][1][m][n][2 * q + 1]} * rs;
                        o[n * 2 + q] = mul_sig_pk(gt * up, gt); }
                u32x2 w; w.x = pk4_fp8(o[0].x, o[0].y, o[1].x, o[1].y); w.y = pk4_fp8(o[2].x, o[2].y, o[3].x, o[3].y);
                *(u32x2*)(HID + (size_t)(u.m0 * 256 + rl) * DE + hc) = w;
            }
    }
};
struct ProbDown {
    static constexpr int K = 256, A_AUX = 0; static constexpr bool PERM = true, GATHER = false, AFTER_DRAIN = false, FP8 = true;
    const unsigned char* HID; const unsigned char* Bt; unsigned char* Y; LAS const int* cs; MoeOrder mo;
    __device__ __forceinline__ bool next(int i, pg8::Unit& u) const { int blk, j, e, bin; if (!mo.locate(i, blk, j, e, bin)) return false;
        u.m0 = blk; u.n0 = j; u.e = e; u.cnt = __builtin_amdgcn_readfirstlane(mo.cn[e]) - bin * 256; u.lb = __builtin_amdgcn_readfirstlane(cs[e]) + bin * 256;
        u.a = (const char*)HID + (size_t)blk * 256 * K * 2; u.b = (const char*)Bt + ((size_t)e * 1024 + j * 256) * K * 2; return true; }
    __device__ __forceinline__ unsigned row_off(const pg8::Unit&, int) const { return 0u; }
    __device__ __forceinline__ void epi(const f32x4 (&acc)[2][2][4][2], const pg8::Unit& u, int wr, int wc, int fr, int fq) const {
        const int col0 = u.n0 * 256 + wc * 32 + 8 * fq;
#pragma unroll
        for (int ai = 0; ai < 2; ++ai)
#pragma unroll
            for (int m = 0; m < 4; ++m) {
                const int rl = ai * 128 + wr * 64 + m * 16 + fr;
                if (rl < u.cnt) {
#pragma unroll
                    for (int bj = 0; bj < 2; ++bj) {
                        const f32x4 a = acc[ai][bj][m][0] * WSCALE_INV, b = acc[ai][bj][m][1] * WSCALE_INV;
                        u32x2 o; o.x = pk4_fp8(a[0], a[1], a[2], a[3]); o.y = pk4_fp8(b[0], b[1], b[2], b[3]);
                        *(u32x2*)(Y + (size_t)(u.lb + rl) * D + col0 + bj * 128) = o; }
                }
            }
    }
};
__device__ __forceinline__ void phase_moe_gu(const Frame& F) {
    moe_tables(F);
    LAS const int* ps = (LAS const int*)(F.lds + PS_OFF); LAS const int* cn = (LAS const int*)(F.lds + CN_OFF); LAS int* tab = (LAS int*)(F.lds + TAB_OFF);
    const int* ltok = (const int*)(F.ws + WS_LTOK);
    const float* lrs = (const float*)(F.ws + WS_LRS);
    ProbGU P; P.H2 = F.ws + WS_X8; P.Bt = F.ws + WS_BTGU; P.HID = F.ws + WS_HID; P.tab = tab;
    P.mo.ps = ps; P.mo.cn = cn; P.mo.nunits = ps[64] * 4; P.mo.G = F.G; P.mo.c = F.bid;
    for (int i = 0; i < MAXU; ++i) { int blk, j, e, bin; if (!P.mo.locate(i, blk, j, e, bin)) break;
        const int cnt = cn[e] - bin * 256;
        if (F.tid < 256) { const int idx = F.tid < cnt ? F.tid : cnt - 1; tab[i * 256 + F.tid] = ltok[e * LCAP + bin * 256 + idx] >> 1; ((LAS float*)tab)[1024 + i * 256 + F.tid] = lrs[e * LCAP + bin * 256 + idx]; } }
    __syncthreads();
    pg8::gemm_phase<ProbGU>(F.lds, P, F.wave, TS_SEL(5));
    Frame G = F; G.lane = lane_id_fresh(); G.tid = G.wave * 64 + G.lane;
    { const int NU = P.mo.nunits, r = NU % G.G, S = (r > 0) ? G.G - r : 0;
      constexpr int SLACK_ITEMS = 40;
      int nslack = S * SLACK_ITEMS; if (nslack > NI_DN) nslack = NI_DN;
      if (S > 0 && G.bid >= r) { const int sidx = G.bid - r; int lo = sidx * SLACK_ITEMS, hi = lo + SLACK_ITEMS; if (lo > nslack) lo = nslack; if (hi > nslack) hi = nslack;
          convert_experts_wave(G, NI_GU + lo, NI_GU + hi, G.wave, NWAVES); }
      convert_experts_wave(G, NI_GU + nslack, NI_GU + NI_DN, G.bid * NWAVES + G.wave, G.G * NWAVES); }
}
__device__ __forceinline__ void phase_moe_down(const Frame& F) {
    moe_tables(F);
    LAS const int* ps = (LAS const int*)(F.lds + PS_OFF); LAS const int* cn = (LAS const int*)(F.lds + CN_OFF);
    ProbDown P; P.HID = F.ws + WS_HID; P.Bt = F.ws + WS_BTD; P.Y = F.ws + WS_Y; P.cs = (LAS const int*)(F.lds + CS_OFF);
    P.mo.ps = ps; P.mo.cn = cn; P.mo.nunits = ps[64] * 4; P.mo.G = F.G; P.mo.c = F.bid;
    pg8::gemm_phase<ProbDown>(F.lds, P, F.wave, TS_SEL(6));
}

__device__ __forceinline__ void phase_final(const Frame& F) {
    moe_tables(F);
    LAS const int* cs = (LAS const int*)(F.lds + CS_OFF);
    const unsigned char* Y = F.ws + WS_Y; const float* route = (const float*)(F.ws + WS_ROUTE); const int* rpos = (const int*)(F.ws + WS_ROUTE2);
    f32x4 g[4];
#pragma unroll
    for (int q = 0; q < 4; ++q) g[q] = *(const f32x4*)(F.g_final + 4 * F.lane + 256 * q);
    for (int row = F.bid * NWAVES + F.wave; row < T; row += F.G * NWAVES) {
        const f32x4 rr = *(const f32x4*)(route + (size_t)row * 4); const int p0 = rpos[2 * row], p1 = rpos[2 * row + 1];
        const float w0 = rr[2], w1 = rr[3];
        const bf16_t* xr = (const bf16_t*)(F.ws + WS_H2) + (size_t)row * D + 4 * F.lane; float* orow = F.out + (size_t)row * D + 4 * F.lane;
        const unsigned char* y0 = Y + (size_t)(cs[(int)rr[0]] + p0) * D + 4 * F.lane; const unsigned char* y1 = Y + (size_t)(cs[(int)rr[1]] + p1) * D + 4 * F.lane;
        f32x4 a[4]; float s = 0.f;
#pragma unroll
        for (int q = 0; q < 4; ++q) { const u32x2 ux = *(const u32x2*)(xr + 256 * q); const unsigned u0 = *(const unsigned*)(y0 + 256 * q), u1 = *(const unsigned*)(y1 + 256 * q);
            const f32x2 y0a = __builtin_amdgcn_cvt_pk_f32_fp8(u0, false), y0b = __builtin_amdgcn_cvt_pk_f32_fp8(u0, true), y1a = __builtin_amdgcn_cvt_pk_f32_fp8(u1, false), y1b = __builtin_amdgcn_cvt_pk_f32_fp8(u1, true);
            a[q][0] = bf_lo(ux.x) + (w0 * y0a.x + w1 * y1a.x); a[q][1] = bf_hi(ux.x) + (w0 * y0a.y + w1 * y1a.y);
            a[q][2] = bf_lo(ux.y) + (w0 * y0b.x + w1 * y1b.x); a[q][3] = bf_hi(ux.y) + (w0 * y0b.y + w1 * y1b.y);
            s += (a[q][0] * a[q][0] + a[q][1] * a[q][1]) + (a[q][2] * a[q][2] + a[q][3] * a[q][3]); }
        const float r = 1.0f / sqrtf(wave_sum(s) * (1.0f / D) + EPS);
#pragma unroll
        for (int q = 0; q < 4; ++q) st_wt16(wt_rsrc(F.out), (unsigned)(((size_t)row * D + 4 * F.lane + 256 * q) * 4), __builtin_bit_cast(u32x4, a[q] * r * g[q]));
    }
}
constexpr int NPHASES = 8;
struct Args { const float* in[15]; float* out; unsigned char* ws; int ph_lo, ph_hi; };
__global__ void __launch_bounds__(NTHR, 2) fwd_kernel(Args args) {
    extern __shared__ __attribute__((aligned(16))) unsigned char lds_raw[];
    Frame F;
    F.lds = (LAS unsigned char*)lds_raw; F.tid = threadIdx.x; F.lane = F.tid & 63; F.wave = __builtin_amdgcn_readfirstlane(F.tid >> 6); F.G = gridDim.x; F.bid = blockIdx.x;
    F.ws = args.ws; F.ctl = (unsigned*)(args.ws + WS_CTL); F.out = args.out;
#ifndef X2_IN_WS
#define X2_IN_WS 0
#endif
    F.x2 = X2_IN_WS ? (float*)(args.ws + WS_X2) : args.out;
    F.x = args.in[0]; F.g_mix = args.in[1]; F.w_in = args.in[2]; F.w_s = args.in[3]; F.b_s = args.in[4]; F.g_sgu = args.in[5]; F.w_conv = args.in[6]; F.w_out = args.in[7];
    F.g_ffn = args.in[8]; F.w_rg = args.in[9]; F.w_re = args.in[10]; F.wg = args.in[11]; F.wu = args.in[12]; F.wd = args.in[13]; F.g_final = args.in[14];
    if (F.tid < 4) ((LAS unsigned*)(F.lds + MISC_OFF))[F.tid] = 0u;
    __syncthreads();
    const int lo = args.ph_lo, hi = args.ph_hi;
    const bool multi = (hi - lo) > 1;
    XcdBarrier bar; bar.bar = F.ctl + CW_BAR; bar.x = 0; bar.st = nullptr; bar.wave = F.wave;
    if (multi) bar = xcd_barrier_post(F.ctl + CW_BAR, (volatile LAS unsigned*)(F.lds + MISC_OFF));
    if (multi && F.tid == 0) (void)__hip_atomic_fetch_or(F.ctl + CW_XMAP + (F.bid & 7), 1u << (xb_xcc_id() & 15u), __ATOMIC_RELAXED, __HIP_MEMORY_SCOPE_AGENT);
    bool all_local = false; unsigned nlocal = 0;
#define IN(k) (lo <= (k) && (k) < hi)
#ifndef PROBE_DOUBLE_BAR
#define PROBE_DOUBLE_BAR 0
#endif
#define SEAM(k) do { F.lane = lane_id_fresh(); F.tid = F.wave * 64 + F.lane;     \
        if (IN(k) && IN((k) + 1)) { \
            if ((k) >= 1 && (k) <= 3 && all_local) { ++nlocal; if ((k) >= 1) group_barrier<false>(F.ctl + CW_GBAR + 16 * (F.bid & 7), nlocal * (unsigned)(F.G >> 3), F.ctl + CW_BAR, F.wave); else group_barrier<true>(F.ctl + CW_GBAR + 16 * (F.bid & 7), nlocal * (unsigned)(F.G >> 3), F.ctl + CW_BAR, F.wave); }     \
            else { xcd_barrier(bar); if (PROBE_DOUBLE_BAR) xcd_barrier(bar); } } } while (0)
    if (IN(0)) { phase_prologue(F); } SEAM(0);
    if (multi && lo == 0 && (F.G & 7) == 0) {
        unsigned ok = 1u;
#pragma unroll
        for (int j = 0; j < 8; ++j) { const unsigned w = __hip_atomic_load(F.ctl + CW_XMAP + j, __ATOMIC_RELAXED, __HIP_MEMORY_SCOPE_AGENT); ok &= (__builtin_popcount(w) == 1) ? 1u : 0u; }
        all_local = __builtin_amdgcn_readfirstlane(ok) != 0u;
    }
    if (IN(1)) {
        ProbProj P; P.A = (const bf16_t*)(F.ws + WS_H); P.Bt = (const bf16_t*)(F.ws + WS_BT1); P.so.init(T, NP, F.G, F.bid);
        P.Pp = (bf16_t*)(F.ws + WS_P); P.Qp = (bf16_t*)(F.ws + WS_Q); P.Rp = (bf16_t*)(F.ws + WS_R); P.Vp = (bf16_t*)(F.ws + WS_V);
        const int nper = (P.so.nwg + F.G - 1) / F.G; int split = 2 * (((F.bid >> 3) & 7) >> 1); if (split > nper) split = nper;
        if (split > 0) { P.ilo = 0; P.ihi = split; pg8::gemm_phase<ProbProj>(F.lds, P, F.wave, TS_SEL(1)); }
        F.lane = lane_id_fresh(); F.tid = F.wave * 64 + F.lane;
        convert_experts_wave(F, 0, NI_GU, F.bid * NWAVES + F.wave, F.G * NWAVES);
        if (split < nper) { P.ilo = split; P.ihi = nper; pg8::gemm_phase<ProbProj>(F.lds, P, F.wave, TS_SEL(1)); }
    } SEAM(1);
    if (IN(2)) { phase_sgu(F); } SEAM(2);
    if (IN(3)) { ProbOut P; P.A = (const bf16_t*)(F.ws + WS_H); P.Bt = (const bf16_t*)(F.ws + WS_BT2); P.so.init(T, D, F.G, F.bid); P.x = F.x; P.H2 = (bf16_t*)(F.ws + WS_H2); P.X8 = F.ws + WS_X8;
        P.WRh = (const bf16_t*)(F.ws + WS_WR); P.PLG = (float*)(F.ws + WS_PLG);
        pg8::gemm_phase<ProbOut>(F.lds, P, F.wave); } SEAM(3);
    if (IN(4)) { phase_router(F); } SEAM(4);
    if (IN(5)) { phase_moe_gu(F); } SEAM(5);
    if (IN(6)) { phase_moe_down(F); } SEAM(6);
    if (IN(7)) { phase_final(F); }
#undef IN
#undef SEAM
}

#if DEBUG_CHECK
#ifndef REF_B
#define REF_B 0
#endif
__global__ void cmp_rows(const void* a, int a_bf16, const float* ref, int rows, float* stat) {
    float d2 = 0.f, r2 = 0.f;
    for (size_t i = (size_t)blockIdx.x * blockDim.x + threadIdx.x; i < (size_t)rows * 1024; i += (size_t)gridDim.x * blockDim.x) {
        const float av = a_bf16 ? __uint_as_float(((unsigned)((const bf16_t*)a)[i]) << 16) : ((const float*)a)[i]; const float rv = ref[i];
        const float d = av - rv; d2 += (d == d) ? d * d : 1e30f; r2 += rv * rv; }
    d2 = wave_sum(d2); r2 = wave_sum(r2);
    if ((threadIdx.x & 63) == 0) { atomicAdd(stat, d2); atomicAdd(stat + 1, r2); }
}
__global__ void cmp_pqrv(const bf16_t* Pp, const bf16_t* Qp, const bf16_t* Rp, const bf16_t* Vp, const float* proj, float* stat) {
    float d2[4] = {0.f, 0.f, 0.f, 0.f}, r2[4] = {0.f, 0.f, 0.f, 0.f};
    for (size_t i = (size_t)blockIdx.x * blockDim.x + threadIdx.x; i < (size_t)2048 * 1024; i += (size_t)gridDim.x * blockDim.x) {
        const size_t t = i >> 10; const int c = (int)(i & 1023); const float* pr = proj + t * 7168;
        const float rf[4] = {nv::gelu_t(pr[c]) * nv::sigm(pr[5120 + c]), pr[2048 + c] * nv::sigm(pr[6144 + c]), pr[3072 + c] * pr[4096 + c], nv::gelu_t(pr[1024 + c])};
        const float av[4] = {__uint_as_float(((unsigned)Pp[i]) << 16), __uint_as_float(((unsigned)Qp[i]) << 16), __uint_as_float(((unsigned)Rp[i]) << 16), __uint_as_float(((unsigned)Vp[i]) << 16)};
#pragma unroll
        for (int k = 0; k < 4; ++k) { const float d = av[k] - rf[k]; d2[k] += (d == d) ? d * d : 1e30f; r2[k] += rf[k] * rf[k]; } }
#pragma unroll
    for (int k = 0; k < 4; ++k) { const float a = wave_sum(d2[k]), b = wave_sum(r2[k]); if ((threadIdx.x & 63) == 0) { atomicAdd(stat + 2 * k, a); atomicAdd(stat + 2 * k + 1, b); } }
}
__global__ void cmp_route(const float* mine, const float* ref, float* stat) {
    const int t = blockIdx.x * blockDim.x + threadIdx.x; if (t >= 2048) return;
    const float a0 = mine[t * 4], a1 = mine[t * 4 + 1], b0 = ref[t * 4], b1 = ref[t * 4 + 1];
    const bool same = (a0 == b0 && a1 == b1) || (a0 == b1 && a1 == b0);
    float gd = 0.f; if (same) { const float w0 = (a0 == b0) ? ref[t * 4 + 2] : ref[t * 4 + 3], w1 = (a0 == b0) ? ref[t * 4 + 3] : ref[t * 4 + 2]; gd = fabsf(mine[t * 4 + 2] - w0) + fabsf(mine[t * 4 + 3] - w1); }
    atomicAdd(stat, same ? 0.f : 1.f); atomicAdd(stat + 1, 0.03f);
    atomicAdd(stat + 2, gd); atomicAdd(stat + 3, 1.0f);
}
__global__ void verdict(float* out, const float* stat, int nstage, size_t n) {
    int bad = 0;
    for (int k = 0; k < nstage; ++k) { const float d = stat[2 * k], r = stat[2 * k + 1]; float tol = 1e-3f; if (k == 7) tol = 1.0f;
        if (!(d <= tol * r)) { bad = k + 1; break; } }
    if (!bad) return;
    for (size_t i = (size_t)blockIdx.x * blockDim.x + threadIdx.x; i < n; i += (size_t)gridDim.x * blockDim.x) out[i] = (float)bad;
}
#endif

#if TSTAT
__global__ void tstat_out(float* out, const float* stat, int sel, size_t n) {
    const float avg = fmaxf(stat[sel] / fmaxf(stat[3], 1.f), 1.f);
    float v = floorf(logf(avg / TS_SCALE) / logf(TS_RATIO)) + 1.f; v = fminf(fmaxf(v, 1.f), 9.f);
    for (size_t i = (size_t)blockIdx.x * blockDim.x + threadIdx.x; i < n; i += (size_t)gridDim.x * blockDim.x) out[i] = v;
}
#endif
extern "C" void kernel_launch(void* const* d_in, const int* in_sizes, int n_in, void* d_out, int out_size, void* d_ws, size_t ws_size, hipStream_t stream) {
    static int grid = 0;
    if (grid == 0) {
        if (n_in != 15 || in_sizes[0] != T * D || out_size != T * D || ws_size < WS_NEED) { fprintf(stderr, "kernel_launch: unexpected problem (n_in %d, in0 %d, out %d, ws %zu)\n", n_in, n_in > 0 ? in_sizes[0] : -1, out_size, ws_size); grid = -1; return; }
        int dev = 0, cus = 0, per_cu = 0;
        if (hipGetDevice(&dev) != hipSuccess || hipDeviceGetAttribute(&cus, hipDeviceAttributeMultiprocessorCount, dev) != hipSuccess) { grid = -1; return; }
        if (hipFuncSetAttribute((const void*)fwd_kernel, hipFuncAttributeMaxDynamicSharedMemorySize, LDS_BYTES) != hipSuccess) { fprintf(stderr, "kernel_launch: hipFuncSetAttribute failed\n"); grid = -1; return; }
        if (hipOccupancyMaxActiveBlocksPerMultiprocessor(&per_cu, (const void*)fwd_kernel, NTHR, LDS_BYTES) != hipSuccess || per_cu < 1) { fprintf(stderr, "kernel_launch: occupancy query says %d\n", per_cu); }
        (void)hipGetLastError();
        grid = cus - (cus % 8);
        if (grid != 256) fprintf(stderr, "kernel_launch: note: %d CUs\n", grid);
    }
    if (grid < 0) return;
    (void)hipMemsetAsync((char*)d_ws + WS_CTL, 0, CTL_ZERO_BYTES, stream);
    Args a{};
    for (int i = 0; i < 15; ++i) a.in[i] = (const float*)d_in[i];
    a.out = (float*)d_out; a.ws = (unsigned char*)d_ws;
#if DEBUG_CHECK
    {
        char* ws = (char*)d_ws; float* stat = (float*)(ws + WS_CTL) + CW_STAT;
        nv::Bufs B; B.h = (float*)(ws + WS_DBG); B.proj = (float*)(ws + WS_DBG + 8 * MiB); B.merged = (float*)(ws + WS_DBG + 64 * MiB); B.x2 = (float*)(ws + WS_DBG + 72 * MiB);
        float* nout = (float*)(ws + WS_DBG + 80 * MiB); float* nroute = (float*)(ws + WS_DBG + 88 * MiB);
        nv::run_seq(d_in, REF_B, B, nout, nroute, stream);
        const size_t ro = (size_t)REF_B * 2048 * 1024;
        for (int p = 0; p < NPHASES; ++p) {
            a.ph_lo = p; a.ph_hi = p + 1;
            hipLaunchKernelGGL(fwd_kernel, dim3(grid), dim3(NTHR), LDS_BYTES, stream, a);
            if (p == 0) hipLaunchKernelGGL(cmp_rows, dim3(256), dim3(256), 0, stream, (const void*)((const bf16_t*)(ws + WS_H) + ro), 1, (const float*)B.h, 2048, stat + 0);
            if (p == 1) hipLaunchKernelGGL(cmp_pqrv, dim3(256), dim3(256), 0, stream, (const bf16_t*)(ws + WS_P) + ro, (const bf16_t*)(ws + WS_Q) + ro, (const bf16_t*)(ws + WS_R) + ro, (const bf16_t*)(ws + WS_V) + ro, (const float*)B.proj, stat + 2);
            if (p == 2) hipLaunchKernelGGL(cmp_rows, dim3(256), dim3(256), 0, stream, (const void*)((const bf16_t*)(ws + WS_H) + ro), 1, (const float*)B.merged, 2048, stat + 10);
            if (p == 3) hipLaunchKernelGGL(cmp_rows, dim3(256), dim3(256), 0, stream, (const void*)((const bf16_t*)(ws + WS_H2) + ro), 1, (const float*)B.x2, 2048, stat + 12);
            if (p == 4) hipLaunchKernelGGL(cmp_route, dim3(8), dim3(256), 0, stream, (const float*)(ws + WS_ROUTE) + (size_t)REF_B * 2048 * 4, (const float*)nroute, stat + 14);
            if (p == 7) hipLaunchKernelGGL(cmp_rows, dim3(256), dim3(256), 0, stream, (const void*)((const float*)d_out + ro), 0, (const float*)nout, 2048, stat + 18);
        }
        hipLaunchKernelGGL(verdict, dim3(256), dim3(256), 0, stream, (float*)d_out, (const float*)stat, 10, (size_t)T * D);
    }
#else
#ifndef N_LAUNCH_PER_PHASE
#define N_LAUNCH_PER_PHASE 1
#endif
#ifndef PROBE_REPEAT
#define PROBE_REPEAT -1
#endif
    if (N_LAUNCH_PER_PHASE) { for (int p = 0; p < NPHASES; ++p) { a.ph_lo = p; a.ph_hi = p + 1; hipLaunchKernelGGL(fwd_kernel, dim3(grid), dim3(NTHR), LDS_BYTES, stream, a);
        if (p == PROBE_REPEAT && p == 4) (void)hipMemsetAsync((char*)d_ws + WS_CTL + CW_GCNT * 4, 0, 256, stream);
        if (p == PROBE_REPEAT) hipLaunchKernelGGL(fwd_kernel, dim3(grid), dim3(NTHR), LDS_BYTES, stream, a); } }
    else { a.ph_lo = 0; a.ph_hi = NPHASES; hipLaunchKernelGGL(fwd_kernel, dim3(grid), dim3(NTHR), LDS_BYTES, stream, a); }
#if TSTAT
    hipLaunchKernelGGL(tstat_out, dim3(256), dim3(256), 0, stream, (float*)d_out, (const float*)((char*)d_ws + WS_CTL) + CW_STAT, TS_COMP, (size_t)T * D);
#endif
#endif
}
```
